# Optimizing an MI355X kernel written in HIP

```python
import math
import jax, jax.numpy as jnp
from jax import lax
import numpy as np

D_MODEL = 1024
BATCH = 16
SEQ = 2048
DEPTH = 4
DEC_BATCH = 8
DEC_SEQ = 16
PAST_LEN = 4096

CHUNK = 64
GM_CHUNK = 128
GM_HEADS = 8
GM_HEAD_DIM = 128
GM_WIDTH = GM_HEADS * GM_HEAD_DIM
SSD_HEADS = 16
SSD_HEAD_DIM = 64
SSD_WIDTH = SSD_HEADS * SSD_HEAD_DIM
SSD_GROUPS = 2
SSD_STATE = 128
CONV_W = 4
CONV_DIM = SSD_WIDTH + 2 * SSD_GROUPS * SSD_STATE
D_MIX = GM_WIDTH + SSD_WIDTH
D_IN_PROJ = 2 * GM_WIDTH + SSD_WIDTH + CONV_DIM + SSD_HEADS
D_FF = 2816
N_MOD = 9
EPS = 1e-6

kernel_name = "hymba_gmlp_ssd_macaron_adaln_stream"


def rmsnorm(x, g):
    xf = x.astype(jnp.float32)
    y = xf * lax.rsqrt(jnp.mean(xf * xf, axis=-1, keepdims=True) + EPS)
    return (y * g.astype(jnp.float32)).astype(x.dtype)


def modulate(h, shift, scale):
    return h * (1 + scale[:, None, :]) + shift[:, None, :]


def swiglu(h, w1, w2):
    g, u = jnp.split(h @ w1, 2, axis=-1)
    return (jax.nn.silu(g) * u) @ w2


def chunk_gmlp(u, v, norm_g, ws, bias):
    bsz, t_len, _ = u.shape
    L = min(GM_CHUNK, t_len)
    nc = t_len // L
    u = jax.nn.gelu(u)
    vf = jax.nn.gelu(v).astype(jnp.float32).reshape(bsz, t_len, GM_HEADS, GM_HEAD_DIM)
    mu = jnp.mean(vf, axis=-1, keepdims=True)
    vc = vf - mu
    var = jnp.mean(vc * vc, axis=-1, keepdims=True)
    vn = (vc * lax.rsqrt(var + EPS)).reshape(bsz, t_len, GM_WIDTH)
    vn = (vn * norm_g.astype(jnp.float32)).astype(u.dtype)
    mask = jnp.tril(jnp.ones((L, L), dtype=bool))
    wm = jnp.where(mask, ws[:, :L, :L], 0.0)
    vb = vn.reshape(bsz, nc, L, GM_HEADS, GM_HEAD_DIM)
    mixed = jnp.einsum('hts,bcshd->bcthd', wm, vb) + bias[:, :L].T[:, :, None]
    return u * mixed.reshape(bsz, t_len, GM_WIDTH), vn


def causal_conv(xbc, buf, w, b):
    t_len = xbc.shape[1]
    xp = jnp.concatenate([buf.astype(xbc.dtype), xbc], axis=1)
    y = sum(xp[:, k:k + t_len] * w[k] for k in range(CONV_W)) + b
    return jax.nn.silu(y), xp[:, t_len:]


def ssd_scan(x, dt, a, bm, cm, h0):
    f32 = jnp.float32
    bsz, t_len = x.shape[:2]
    L = min(CHUNK, t_len)
    nc = t_len // L
    hg = SSD_HEADS // SSD_GROUPS
    xr = x.astype(f32).reshape(bsz, nc, L, SSD_GROUPS, hg, SSD_HEAD_DIM)
    dtr = dt.astype(f32).reshape(bsz, nc, L, SSD_GROUPS, hg)
    br = bm.astype(f32).reshape(bsz, nc, L, SSD_GROUPS, SSD_STATE)
    cr = cm.astype(f32).reshape(bsz, nc, L, SSD_GROUPS, SSD_STATE)
    a_cum = jnp.cumsum(dtr * a.astype(f32).reshape(SSD_GROUPS, hg), axis=2)
    xdt = xr * dtr[..., None]
    ac = jnp.transpose(a_cum, (0, 1, 3, 4, 2))
    mask = jnp.tril(jnp.ones((L, L), dtype=bool))
    seg = ac[..., :, None] - ac[..., None, :]
    decay = jnp.exp(jnp.where(mask, seg, -jnp.inf))
    cb = jnp.einsum('bclgn,bcsgn->bcgls', cr, br)
    y_diag = jnp.einsum('bcgls,bcghls,bcsghp->bclghp', cb, decay, xdt)
    decay_states = jnp.exp(a_cum[:, :, -1:] - a_cum)
    states = jnp.einsum('bcsgn,bcsgh,bcsghp->bcghpn', br, decay_states, xdt)
    chunk_decay = jnp.exp(a_cum[:, :, -1])
    h0r = h0.astype(f32).reshape(bsz, SSD_GROUPS, hg, SSD_HEAD_DIM, SSD_STATE)

    def step(h, inp):
        st, dec = inp
        return dec[..., None, None] * h + st, h

    h_final, h_prev = lax.scan(step, h0r, (jnp.swapaxes(states, 0, 1), jnp.swapaxes(chunk_decay, 0, 1)))
    h_prev = jnp.swapaxes(h_prev, 0, 1)
    y_off = jnp.einsum('bclgn,bclgh,bcghpn->bclghp', cr, jnp.exp(a_cum), h_prev)
    y = (y_diag + y_off).reshape(bsz, t_len, SSD_HEADS, SSD_HEAD_DIM)
    return y, h_final.reshape(bsz, SSD_HEADS, SSD_HEAD_DIM, SSD_STATE)


def hybrid_mixer(h, ssm0, conv0, w_in, gm_norm_g, gm_ws, gm_b, conv_w, conv_b,
                 dt_bias, a_log, d_skip, ssd_norm_g, w_out):
    f32 = jnp.float32
    bsz, t_len, _ = h.shape
    proj = h @ w_in
    s1 = GM_WIDTH
    s2 = 2 * GM_WIDTH
    s3 = s2 + SSD_WIDTH
    s4 = s3 + CONV_DIM
    u, v, z, xbc, dt_raw = jnp.split(proj, [s1, s2, s3, s4], axis=-1)
    gm_out, gm_v = chunk_gmlp(u, v, gm_norm_g, gm_ws, gm_b)
    xbc_c, conv_new = causal_conv(xbc, conv0, conv_w, conv_b)
    xs, bm, cm = jnp.split(xbc_c, [SSD_WIDTH, SSD_WIDTH + SSD_GROUPS * SSD_STATE], axis=-1)
    xs = xs.reshape(bsz, t_len, SSD_HEADS, SSD_HEAD_DIM)
    dt = jax.nn.softplus(dt_raw.astype(f32) + dt_bias.astype(f32))
    a = -jnp.exp(a_log.astype(f32))
    y, ssm_new = ssd_scan(xs, dt, a,
                          bm.reshape(bsz, t_len, SSD_GROUPS, SSD_STATE),
                          cm.reshape(bsz, t_len, SSD_GROUPS, SSD_STATE), ssm0)
    y = y + d_skip.astype(f32)[:, None] * xs.astype(f32)
    y = y.reshape(bsz, t_len, SSD_WIDTH) * jax.nn.silu(z.astype(f32))
    y = rmsnorm(y, ssd_norm_g).astype(h.dtype)
    out = jnp.concatenate([gm_out, y], axis=-1) @ w_out
    return out, ssm_new.astype(ssm0.dtype), conv_new, gm_v


def run_trunk(x, c, ssm_init, conv_init, keep_v, w_ada, b_ada, norm_g, ffn_w1, ffn_w2, w_in,
              gm_norm_g, gm_ws, gm_b, conv_w, conv_b, dt_bias, a_log, d_skip, ssd_norm_g,
              w_out, final_norm_g, w_ada_final, b_ada_final):
    sc = jax.nn.silu(c)
    ssm_out, conv_out, v_out = [], [], []
    for l in range(DEPTH):
        mod = sc @ w_ada[l] + b_ada[l]
        sh1, sc1, g1, sh2, sc2, g2, sh3, sc3, g3 = jnp.split(mod, N_MOD, axis=-1)
        hn = modulate(rmsnorm(x, norm_g[l, 0]), sh1, sc1)
        x = x + 0.5 * g1[:, None, :] * swiglu(hn, ffn_w1[l, 0], ffn_w2[l, 0])
        hn = modulate(rmsnorm(x, norm_g[l, 1]), sh2, sc2)
        m, ssm_l, conv_l, v_l = hybrid_mixer(hn, ssm_init[l], conv_init[l], w_in[l], gm_norm_g[l],
                                             gm_ws[l], gm_b[l], conv_w[l], conv_b[l], dt_bias[l],
                                             a_log[l], d_skip[l], ssd_norm_g[l], w_out[l])
        x = x + g2[:, None, :] * m
        hn = modulate(rmsnorm(x, norm_g[l, 2]), sh3, sc3)
        x = x + 0.5 * g3[:, None, :] * swiglu(hn, ffn_w1[l, 1], ffn_w2[l, 1])
        ssm_out.append(ssm_l)
        conv_out.append(conv_l)
        if keep_v:
            v_out.append(v_l)
    shf, scf = jnp.split(sc @ w_ada_final + b_ada_final, 2, axis=-1)
    y = modulate(rmsnorm(x, final_norm_g), shf, scf)
    v_stack = jnp.stack(v_out) if keep_v else None
    return y, jnp.stack(ssm_out), jnp.stack(conv_out), v_stack


def setup_inputs(seed: int = 0) -> dict:
    key = jax.random.key(seed)
    ks = jax.random.split(key, 25)
    f32 = jnp.float32

    def nrm(k, shape, s):
        return jax.random.normal(k, shape, f32) * s

    dt0 = jnp.exp(jax.random.uniform(ks[17], (DEPTH, SSD_HEADS), f32, math.log(1e-3), math.log(1e-1)))
    return {
        "x_prompt": nrm(ks[0], (BATCH, SEQ, D_MODEL), 1.0),
        "x_sample": nrm(ks[1], (DEC_BATCH, DEC_SEQ, D_MODEL), 1.0),
        "state_ssm": nrm(ks[2], (DEPTH, DEC_BATCH, SSD_HEADS, SSD_HEAD_DIM, SSD_STATE), 0.1),
        "state_conv": nrm(ks[3], (DEPTH, DEC_BATCH, CONV_W - 1, CONV_DIM), 0.5),
        "c_prompt": nrm(ks[4], (BATCH, D_MODEL), 1.0),
        "c_sample": nrm(ks[5], (DEC_BATCH, D_MODEL), 1.0),
        "w_ada": nrm(ks[6], (DEPTH, D_MODEL, N_MOD * D_MODEL), 0.5 * D_MODEL ** -0.5),
        "b_ada": nrm(ks[7], (DEPTH, N_MOD * D_MODEL), 0.02),
        "norm_g": 1.0 + nrm(ks[8], (DEPTH, 3, D_MODEL), 0.02),
        "ffn_w1": nrm(ks[9], (DEPTH, 2, D_MODEL, 2 * D_FF), D_MODEL ** -0.5),
        "ffn_w2": nrm(ks[10], (DEPTH, 2, D_FF, D_MODEL), D_FF ** -0.5),
        "w_in": nrm(ks[11], (DEPTH, D_MODEL, D_IN_PROJ), D_MODEL ** -0.5),
        "gm_norm_g": 1.0 + nrm(ks[12], (DEPTH, GM_WIDTH), 0.02),
        "gm_ws": nrm(ks[13], (DEPTH, GM_HEADS, GM_CHUNK, GM_CHUNK), GM_CHUNK ** -0.5),
        "gm_b": 1.0 + nrm(ks[14], (DEPTH, GM_HEADS, GM_CHUNK), 0.02),
        "conv_w": nrm(ks[15], (DEPTH, CONV_W, CONV_DIM), CONV_W ** -0.5),
        "conv_b": nrm(ks[16], (DEPTH, CONV_DIM), 0.02),
        "dt_bias": dt0 + jnp.log(-jnp.expm1(-dt0)),
        "a_log": jnp.log(jax.random.uniform(ks[18], (DEPTH, SSD_HEADS), f32, 1.0, 16.0)),
        "d_skip": 1.0 + nrm(ks[19], (DEPTH, SSD_HEADS), 0.1),
        "ssd_norm_g": 1.0 + nrm(ks[20], (DEPTH, SSD_WIDTH), 0.02),
        "w_out": nrm(ks[21], (DEPTH, D_MIX, D_MODEL), D_MIX ** -0.5),
        "final_norm_g": 1.0 + nrm(ks[22], (D_MODEL,), 0.02),
        "w_ada_final": nrm(ks[23], (D_MODEL, 2 * D_MODEL), 0.5 * D_MODEL ** -0.5),
        "b_ada_final": nrm(ks[24], (2 * D_MODEL,), 0.02),
    }


def reference(x_prompt, x_sample, state_ssm, state_conv, c_prompt, c_sample, w_ada, b_ada, norm_g,
              ffn_w1, ffn_w2, w_in, gm_norm_g, gm_ws, gm_b, conv_w, conv_b, dt_bias, a_log, d_skip,
              ssd_norm_g, w_out, final_norm_g, w_ada_final, b_ada_final):
    params = (w_ada, b_ada, norm_g, ffn_w1, ffn_w2, w_in, gm_norm_g, gm_ws, gm_b, conv_w, conv_b,
              dt_bias, a_log, d_skip, ssd_norm_g, w_out, final_norm_g, w_ada_final, b_ada_final)
    bp = x_prompt.shape[0]
    ssm0 = jnp.zeros((DEPTH, bp, SSD_HEADS, SSD_HEAD_DIM, SSD_STATE), state_ssm.dtype)
    conv0 = jnp.zeros((DEPTH, bp, CONV_W - 1, CONV_DIM), state_conv.dtype)
    y_prompt, ssm_prompt, conv_prompt, _ = run_trunk(x_prompt, c_prompt, ssm0, conv0, False, *params)
    y_sample, ssm_sample, conv_sample, gm_v_sample = run_trunk(x_sample, c_sample, state_ssm, state_conv,
                                                               True, *params)
    return (y_prompt, y_sample, ssm_prompt, conv_prompt, ssm_sample, conv_sample, gm_v_sample)
```

```cpp
#include <hip/hip_runtime.h>
#include <hip/hip_cooperative_groups.h>
#include <cstdio>
namespace cg = cooperative_groups;

#ifndef MK_MULTI
#define MK_MULTI 0
#endif

typedef unsigned short bf16_t;
typedef short bf16x8 __attribute__((ext_vector_type(8)));
typedef float f32x4 __attribute__((ext_vector_type(4)));
typedef float f32x16 __attribute__((ext_vector_type(16)));
typedef unsigned u32x4 __attribute__((ext_vector_type(4)));
typedef unsigned u32x2 __attribute__((ext_vector_type(2)));

constexpr int DM = 1024, MP = 32768  , MV = 32896  , MPAD = 33024  ;
constexpr int DFF = 2816, DIN = 4624, DINP = 4864, PROJW = 4608, NPH = 46;
constexpr int LDS_BYTES = 131072 + 3072;
constexpr size_t O_YS = 33554432, O_SSMP = 33685504, O_CONVP = 42074112, O_SSMS = 42369024, O_CONVS = 46563328, O_GMV = 46710784;
constexpr size_t WS_WB1 = 0;
constexpr size_t WS_WB2 = WS_WB1 + (size_t)8 * 5632 * 1024 * 2;
constexpr size_t WS_WBIN = WS_WB2 + (size_t)8 * 1024 * 2816 * 2;
constexpr size_t WS_WBOUT = WS_WBIN + (size_t)4 * DINP * 1024 * 2;
constexpr size_t WS_WM = WS_WBOUT + (size_t)4 * 1024 * 2048 * 2;
constexpr size_t WS_MOD = WS_WM + (size_t)4 * 8 * 128 * 128 * 2;
constexpr size_t WS_MODF = WS_MOD + (size_t)4 * 24 * 9216 * 4;
constexpr size_t WS_PROJ = WS_MODF + (size_t)24 * 2048 * 4;
constexpr size_t WS_DT = WS_PROJ + (size_t)MPAD * PROJW * 2;
constexpr size_t WS_BC = WS_DT + (size_t)MPAD * 16 * 4;
constexpr size_t WS_A2 = WS_BC + (size_t)MPAD * 512 * 2;
constexpr size_t WS_SSQ = WS_A2 + (size_t)MPAD * 2048 * 2;
constexpr size_t WS_END = WS_SSQ + (size_t)MPAD * 16 * 4;

struct Params { const float* in[25]; float* out; unsigned char* ws; int ph_lo, ph_hi; };

__device__ __forceinline__ float silu_f(float x) { return x / (1.f + __expf(-x)); }
__device__ __forceinline__ float gelu_t(float x) { const float y = 0.7978845608028654f * (x + 0.044715f * x * x * x); const float e = __expf(2.f * y); const float th = 1.f - 2.f / (e + 1.f); return 0.5f * x * (1.f + th); }
__device__ __forceinline__ float softplus_f(float x) { return fmaxf(x, 0.f) + log1pf(__expf(-fabsf(x))); }
__device__ __forceinline__ float bflo(unsigned w) { return __uint_as_float(w << 16); }
__device__ __forceinline__ float bfhi(unsigned w) { return __uint_as_float(w & 0xffff0000u); }
__device__ __forceinline__ unsigned pk2(float lo, float hi) { unsigned r; asm volatile("v_cvt_pk_bf16_f32 %0, %1, %2" : "=v"(r) : "v"(lo), "v"(hi)); return r; }
__device__ __forceinline__ int modrow(int row) { int r = row < MP ? (row >> 11) : 16 + ((row - MP) >> 4); return r > 23 ? 23 : r; }

namespace pg8 {
#define PG8_LAS __attribute__((address_space(3)))
typedef unsigned short bf16_t;
typedef short bf16x8 __attribute__((ext_vector_type(8)));
typedef float f32x4 __attribute__((ext_vector_type(4)));
typedef unsigned u32x4 __attribute__((ext_vector_type(4)));
constexpr int BM = 256, BK = 64, HALF = 128, HTB = HALF * BK * 2  , STAGE_BYTES = 8 * HTB, NXCD = 8, WGM = 8;

__host__ __device__ __forceinline__ int lds_byte(int r, int c) { const int st = (r >> 4) * 2 + (c >> 5), rr = r & 15, cc = c & 31, ob = rr * 64 + cc * 2; return st * 1024 + (ob ^ (((ob >> 9) & 1) << 5)); }
__host__ __device__ __forceinline__ void stage_rc(int b, int& R, int& C) { const int st = b / 1024, sb = b % 1024, swz = sb ^ (((sb >> 9) & 1) << 5); R = (st >> 1) * 16 + swz / 64; C = (st & 1) * 32 + (swz % 64) / 2; }
__host__ __device__ __forceinline__ int perm32(int rho) { const int n = rho >> 4, i = rho & 15; return 8 * (i >> 2) + 4 * n + (i & 3); }
struct Unit { int pm, pn; };
struct Gemm { const bf16_t* A; const bf16_t* Bt; int M, N, K; };
struct StaticOrder {
    int nM, nN, nwg, G, c;
    __host__ __device__ void init(int M, int N, int G_, int c_) { nM = M / BM; nN = N / BM; nwg = nM * nN; G = G_; c = c_; }
    __host__ __device__ bool next(int i, Unit& u) const {
        const long L = (long)i * G + c; if (L >= nwg) return false;
        int wgid = (int)L; { const int q = nwg / NXCD, r = nwg % NXCD, xcd = wgid % NXCD, off = wgid / NXCD; wgid = (xcd < r ? xcd * (q + 1) : r * (q + 1) + (xcd - r) * q) + off; }
        const int nig = WGM * nN, gid = wgid / nig, fm = gid * WGM, gsz = (nM - fm) < WGM ? (nM - fm) : WGM;
        u.pm = fm + ((wgid % nig) % gsz); u.pn = (wgid % nig) / gsz; return true;
    }
    __device__ __forceinline__ void a_ready(const Unit&) const {}
    __device__ __forceinline__ void done(const Unit&) const {}
};
__device__ __forceinline__ unsigned cvt_pk_bf16(float lo, float hi) { unsigned r; asm volatile("v_cvt_pk_bf16_f32 %0, %1, %2" : "=v"(r) : "v"(lo), "v"(hi)); return r; }
typedef float f32x2 __attribute__((ext_vector_type(2)));
template <class Epi, class Sched, bool STAMP = false>
__device__ __forceinline__ void gemm_phase(PG8_LAS unsigned char* lds, const Gemm g, const Sched& S, const Epi& E, unsigned long long* stamps) {
    int tid_raw = threadIdx.x; asm volatile("" : "+v"(tid_raw));
    const int tid = tid_raw, wid = __builtin_amdgcn_readfirstlane(tid >> 6), lane = tid & 63, wr = wid >> 2, wc = wid & 3, fr = lane & 15, fq = lane >> 4;
    const int K = g.K, nt = K / BK;
    int ts_lo = 0, ts_hi = 0, nts = 0; const unsigned long long rt_entry = STAMP ? (unsigned long long)wall_clock64() : 0ull;
#define PG8_STAMP() do { if (STAMP && wid == 0 && nts < 64) { const unsigned long long _c = (unsigned long long)clock64(); \
        ts_lo = (lane == nts) ? (int)(unsigned)_c : ts_lo; ts_hi = (lane == nts) ? (int)(unsigned)(_c >> 32) : ts_hi; ++nts; } } while (0)
    PG8_STAMP();
    unsigned voffA[2], voffB[2];
#pragma unroll
    for (int i = 0; i < 2; ++i) { int R, C; stage_rc(tid * 16 + i * 8192, R, C); const int Rb = Epi::PERM ? ((R & ~31) + perm32(R & 31)) : R;
        voffA[i] = (unsigned)(R * K + C) * 2u; voffB[i] = (unsigned)(Rb * K + C) * 2u; }
    const size_t kstep = (size_t)(BK * 2);
    const size_t hstep = (size_t)HALF * K * 2;
    const size_t tstep = 2 * hstep;
    const unsigned ldsw = (unsigned)wid * 1024u;
    const int aoff = lds_byte(wr * 64 + fr, fq * 8), boff = lds_byte(wc * 32 + fr, fq * 8);
#define PG8_SA(b, h) (((b) * 2 + (h)) * HTB)
#define PG8_SB(b, h) ((4 + (b) * 2 + (h)) * HTB)
#define PG8_STAGE(bufoff, gbase, voff) do { _Pragma("unroll") for (int _i = 0; _i < 2; ++_i) \
        __builtin_amdgcn_global_load_lds((const unsigned*)((const char*)(gbase) + (voff)[_i]), (PG8_LAS unsigned*)(lds + (bufoff) + ldsw + _i * 8192), 16, 0, 0); } while (0)
#define PG8_LDA(dst, b, h) do { _Pragma("unroll") for (int m = 0; m < 4; ++m) _Pragma("unroll") for (int k = 0; k < 2; ++k) dst[m][k] = *(const PG8_LAS bf16x8*)(lds + PG8_SA(b, h) + aoff + m * 2048 + k * 1024); } while (0)
#define PG8_LDB(dst, b, h) do { _Pragma("unroll") for (int n = 0; n < 2; ++n) _Pragma("unroll") for (int k = 0; k < 2; ++k) dst[n][k] = *(const PG8_LAS bf16x8*)(lds + PG8_SB(b, h) + boff + n * 2048 + k * 1024); } while (0)
#define PG8_MMA(ai, bj, At, Bt) do { __builtin_amdgcn_s_setprio(1); _Pragma("unroll") for (int m = 0; m < 4; ++m) _Pragma("unroll") for (int n = 0; n < 2; ++n) _Pragma("unroll") for (int k = 0; k < 2; ++k) \
        acc[ai][bj][m][n] = __builtin_amdgcn_mfma_f32_16x16x32_bf16(Bt[n][k], At[m][k], acc[ai][bj][m][n], 0, 0, 0); __builtin_amdgcn_s_setprio(0); } while (0)
#define PG8_WAIT_V(n) asm volatile("s_waitcnt vmcnt(" #n ")" ::: "memory")
#define PG8_WAIT_L(n) asm volatile("s_waitcnt lgkmcnt(" #n ")" ::: "memory")
#define PG8_BAR __builtin_amdgcn_s_barrier()
#define PG8_SCHED __builtin_amdgcn_sched_barrier(0)
    Unit cur, nxt; int ui = 0;
    if (!S.next(0, cur)) return;
    f32x4 acc[2][2][4][2];
#pragma unroll
    for (int a = 0; a < 2; ++a)
#pragma unroll
        for (int b = 0; b < 2; ++b)
#pragma unroll
            for (int m = 0; m < 4; ++m)
#pragma unroll
                for (int n = 0; n < 2; ++n) acc[a][b][m][n] = (f32x4){0.f, 0.f, 0.f, 0.f};
    bf16x8 At[4][2], B0[2][2], B1[2][2];
    const char* cA = (const char*)g.A + (size_t)cur.pm * tstep; const char* cB = (const char*)g.Bt + (size_t)cur.pn * tstep;
    S.a_ready(cur);
    PG8_STAGE(PG8_SB(0, 0), cB, voffB); PG8_STAGE(PG8_SA(0, 0), cA, voffA); PG8_STAGE(PG8_SB(0, 1), cB + hstep, voffB); PG8_STAGE(PG8_SA(0, 1), cA + hstep, voffA);
    if (wr == 1) PG8_BAR;
    PG8_WAIT_V(4); PG8_BAR;
    PG8_STAGE(PG8_SB(1, 0), cB + kstep, voffB); PG8_STAGE(PG8_SA(1, 0), cA + kstep, voffA); PG8_STAGE(PG8_SB(1, 1), cB + hstep + kstep, voffB);
    PG8_WAIT_V(6); PG8_BAR;
    PG8_STAMP();
    for (;;) {
        const bool has_next = S.next(ui + 1, nxt);
        const char* nA = has_next ? (const char*)g.A + (size_t)nxt.pm * tstep : cA; const char* nB = has_next ? (const char*)g.Bt + (size_t)nxt.pn * tstep : cB;
        for (int t = 0; t < nt; t += 2) {
            if constexpr (Epi::MIDK) { if (t == E.midk_t) E.mid(acc, ui, wr, wc, fr, fq); }
            const bool last = (t == nt - 2);
            const char* a1 = cA + (size_t)(t + 1) * kstep;
            const char* a2 = last ? nA : cA + (size_t)(t + 2) * kstep; const char* b2 = last ? nB : cB + (size_t)(t + 2) * kstep;
            const char* a3 = a2 + kstep; const char* b3 = b2 + kstep;
            if (last && has_next) S.a_ready(nxt);
            PG8_LDB(B0, 0, 0); PG8_SCHED; PG8_LDA(At, 0, 0); PG8_STAGE(PG8_SA(1, 1), a1 + hstep, voffA);
            PG8_WAIT_L(8); PG8_BAR; PG8_WAIT_L(0); PG8_MMA(0, 0, At, B0); PG8_BAR; PG8_SCHED;
            PG8_LDB(B1, 0, 1); PG8_STAGE(PG8_SB(0, 0), b2, voffB);
            PG8_BAR; PG8_WAIT_L(0); PG8_MMA(0, 1, At, B1); PG8_BAR;
            PG8_LDA(At, 0, 1); PG8_STAGE(PG8_SA(0, 0), a2, voffA);
            PG8_BAR; PG8_WAIT_L(0); PG8_MMA(1, 0, At, B0); PG8_BAR; PG8_SCHED;
            PG8_STAGE(PG8_SB(0, 1), b2 + hstep, voffB);
            PG8_WAIT_V(6); PG8_BAR; PG8_MMA(1, 1, At, B1); PG8_BAR;
            PG8_LDB(B0, 1, 0); PG8_SCHED; PG8_LDA(At, 1, 0); PG8_STAGE(PG8_SA(0, 1), a2 + hstep, voffA);
            PG8_WAIT_L(8); PG8_BAR; PG8_WAIT_L(0); PG8_MMA(0, 0, At, B0); PG8_BAR; PG8_SCHED;
            PG8_LDB(B1, 1, 1); PG8_STAGE(PG8_SB(1, 0), b3, voffB);
            PG8_BAR; PG8_WAIT_L(0); PG8_MMA(0, 1, At, B1); PG8_BAR;
            PG8_LDA(At, 1, 1); PG8_STAGE(PG8_SA(1, 0), a3, voffA);
            PG8_BAR; PG8_WAIT_L(0); PG8_MMA(1, 0, At, B0); PG8_BAR; PG8_SCHED;
            PG8_STAGE(PG8_SB(1, 1), b3 + hstep, voffB);
            PG8_WAIT_V(6); PG8_BAR; PG8_MMA(1, 1, At, B1); PG8_BAR;
        }
        PG8_STAMP();
        if constexpr (!Epi::AFTER_DRAIN) { E(acc, cur, wr, wc, fr, fq); S.done(cur); }
        PG8_STAMP();
        if (!has_next) break;
#pragma unroll
        for (int a = 0; a < 2; ++a)
#pragma unroll
            for (int b = 0; b < 2; ++b)
#pragma unroll
                for (int m = 0; m < 4; ++m)
#pragma unroll
                    for (int n = 0; n < 2; ++n) acc[a][b][m][n] = (f32x4){0.f, 0.f, 0.f, 0.f};
        cur = nxt; cA = nA; cB = nB; ++ui;
    }
    PG8_WAIT_V(0);
    if (wr == 0) PG8_BAR;
    PG8_BAR;
    if constexpr (Epi::AFTER_DRAIN) { E.fused(acc, cur, wr, wc, fr, fq, lds, wid, lane); S.done(cur); }
    PG8_STAMP();
    if (STAMP && wid == 0) { stamps[lane] = lane < nts ? (((unsigned long long)(unsigned)ts_hi << 32) | (unsigned)ts_lo) : 0ull;
        if (lane == 62) stamps[62] = rt_entry; if (lane == 63) stamps[63] = (unsigned long long)wall_clock64(); }
#undef PG8_STAMP
#undef PG8_SA
#undef PG8_SB
#undef PG8_STAGE
#undef PG8_LDA
#undef PG8_LDB
#undef PG8_MMA
#undef PG8_WAIT_V
#undef PG8_WAIT_L
#undef PG8_BAR
#undef PG8_SCHED
}
}

struct EpiSwiglu {
    static constexpr bool PERM = true, AFTER_DRAIN = false, MIDK = false;
    bf16_t* H; int midk_t;
    __device__ __forceinline__ void operator()(const f32x4 (&acc)[2][2][4][2], const pg8::Unit& u, int wr, int wc, int fr, int fq) const {
        const int row0 = u.pm * 256 + wr * 64 + fr, col0 = u.pn * 128 + wc * 32 + 8 * fq;
#pragma unroll
        for (int ai = 0; ai < 2; ++ai)
#pragma unroll
            for (int m = 0; m < 4; ++m) {
                bf16_t* rowp = H + (size_t)(row0 + ai * 128 + m * 16) * DFF + col0;
                const f32x4 g0 = acc[ai][0][m][0], g1 = acc[ai][0][m][1], u0 = acc[ai][1][m][0], u1 = acc[ai][1][m][1];
                u32x4 w;
                w.x = pk2(silu_f(g0[0]) * u0[0], silu_f(g0[1]) * u0[1]); w.y = pk2(silu_f(g0[2]) * u0[2], silu_f(g0[3]) * u0[3]);
                w.z = pk2(silu_f(g1[0]) * u1[0], silu_f(g1[1]) * u1[1]); w.w = pk2(silu_f(g1[2]) * u1[2], silu_f(g1[3]) * u1[3]);
                *(u32x4*)rowp = w;
            }
    }
};
template <bool MID> struct EpiResid {
    static constexpr bool PERM = false, AFTER_DRAIN = false, MIDK = MID;
    float* X; const float* gate; float coef; const float* rinv; int midk_t;
    __device__ __forceinline__ void operator()(const f32x4 (&acc)[2][2][4][2], const pg8::Unit& u, int wr, int wc, int fr, int fq) const {
        const int col0 = u.pn * 256 + wc * 32 + 4 * fq;
#pragma unroll
        for (int ai = 0; ai < 2; ++ai)
#pragma unroll
            for (int m = 0; m < 4; ++m) {
                const int row = u.pm * 256 + ai * 128 + wr * 64 + m * 16 + fr;
                if (row < MV) {
                    float* xp = X + (size_t)row * DM + col0; const float* gp = gate + (size_t)modrow(row) * 9216 + col0;
#pragma unroll
                    for (int bj = 0; bj < 2; ++bj)
#pragma unroll
                        for (int n = 0; n < 2; ++n) { const int off = bj * 128 + n * 16; const f32x4 xv = *(const f32x4*)(xp + off), gv = *(const f32x4*)(gp + off); *(f32x4*)(xp + off) = xv + coef * gv * acc[ai][bj][m][n]; }
                }
                asm volatile("" ::: "memory");
            }
    }
    __device__ __forceinline__ void mid(f32x4 (&acc)[2][2][4][2], int ui, int wr, int wc, int fr, int fq) const {
        const float* rl = rinv + ui * 256 + wr * 64 + fr;
#pragma unroll
        for (int ai = 0; ai < 2; ++ai)
#pragma unroll
            for (int m = 0; m < 4; ++m) {
                const float r = rl[ai * 128 + m * 16];
#pragma unroll
                for (int bj = 0; bj < 2; ++bj)
#pragma unroll
                    for (int n = 0; n < 2; ++n) acc[ai][bj][m][n] *= r;
            }
    }
};
struct EpiProj {
    static constexpr bool PERM = true, AFTER_DRAIN = false, MIDK = false;
    bf16_t* P; float* DT; int midk_t;
    __device__ __forceinline__ void operator()(const f32x4 (&acc)[2][2][4][2], const pg8::Unit& u, int wr, int wc, int fr, int fq) const {
        const int row0 = u.pm * 256 + wr * 64 + fr;
        if (u.pn < 18) {
            const int col0 = u.pn * 256 + wc * 32 + 8 * fq;
#pragma unroll
            for (int ai = 0; ai < 2; ++ai)
#pragma unroll
                for (int m = 0; m < 4; ++m) {
                    bf16_t* rowp = P + (size_t)(row0 + ai * 128 + m * 16) * PROJW + col0;
#pragma unroll
                    for (int bj = 0; bj < 2; ++bj) { const f32x4 v0 = acc[ai][bj][m][0], v1 = acc[ai][bj][m][1]; u32x4 w; w.x = pk2(v0[0], v0[1]); w.y = pk2(v0[2], v0[3]); w.z = pk2(v1[0], v1[1]); w.w = pk2(v1[2], v1[3]); *(u32x4*)(rowp + bj * 128) = w; }
                }
        } else if (wc == 0 && fq < 2) {
#pragma unroll
            for (int ai = 0; ai < 2; ++ai)
#pragma unroll
                for (int m = 0; m < 4; ++m) { float* dp = DT + (size_t)(row0 + ai * 128 + m * 16) * 16 + 8 * fq; *(f32x4*)dp = acc[ai][0][m][0]; *(f32x4*)(dp + 4) = acc[ai][0][m][1]; }
        }
    }
};

__device__ __forceinline__ void p0_gemv(const Params& p, int u, int wid, int lane) {
    const float* src; const float* bias; float* dst; int ld, n0;
    if (u < 144) { const int l = u / 36; n0 = (u % 36) * 256; src = p.in[6] + (size_t)l * 1024 * 9216; bias = p.in[7] + l * 9216; dst = (float*)(p.ws + WS_MOD) + (size_t)l * 24 * 9216; ld = 9216; }
    else { n0 = (u - 144) * 256; src = p.in[23]; bias = p.in[24]; dst = (float*)(p.ws + WS_MODF); ld = 2048; }
    const int i = lane & 31, kh = lane >> 5; const bool valid = i < 24;
    const float* cptr = i < 16 ? p.in[4] + i * 1024 : p.in[5] + ((valid ? i : 16) - 16) * 1024;
    const int n = n0 + wid * 32 + i;
    f32x16 acc; for (int r = 0; r < 16; ++r) acc[r] = 0.f;
    const float* sp = src + n + (size_t)kh * ld;
#pragma unroll 8
    for (int k0 = 0; k0 < 1024; k0 += 2) {
        const float cv = cptr[k0 + kh]; const float a = valid ? silu_f(cv) : 0.f; const float b = sp[(size_t)k0 * ld];
        acc = __builtin_amdgcn_mfma_f32_32x32x2f32(a, b, acc, 0, 0, 0);
    }
    const float bv = bias[n];
#pragma unroll
    for (int r = 0; r < 16; ++r) { const int row = (r & 3) + 8 * (r >> 2) + 4 * kh; if (row < 24) dst[(size_t)row * ld + n] = acc[r] + bv; }
}
__device__ __forceinline__ void p0_cvt(const Params& p, int idx, unsigned char* smem, int tid) {
    const float* src; bf16_t* dst; const float* scale = nullptr; int ld_src, ldd, srccol0, k0s, R0, kk0, ncol = 1 << 30;
    if (idx < 11264) { const int m = idx / 1408, rem = idx % 1408, tn = rem >> 4, tk = rem & 15; R0 = 64 * tn; kk0 = 64 * tk; k0s = kk0;
        srccol0 = ((R0 >> 7) & 1) * DFF + 128 * (R0 >> 8) + (R0 & 127); src = p.in[9] + (size_t)m * 1024 * 5632; ld_src = 5632; dst = (bf16_t*)(p.ws + WS_WB1) + (size_t)m * 5632 * 1024; ldd = 1024; }
    else if (idx < 16896) { idx -= 11264; const int m = idx / 704, rem = idx % 704, tn = rem / 44, tk = rem % 44; R0 = 64 * tn; kk0 = 64 * tk; k0s = kk0; srccol0 = R0;
        src = p.in[10] + (size_t)m * DFF * 1024; ld_src = 1024; dst = (bf16_t*)(p.ws + WS_WB2) + (size_t)m * 1024 * DFF; ldd = DFF; }
    else if (idx < 21760) { idx -= 16896; const int l = idx / 1216, rem = idx % 1216, tn = rem >> 4, tk = rem & 15; R0 = 64 * tn; kk0 = 64 * tk; k0s = kk0; srccol0 = R0; ncol = DIN;
        src = p.in[11] + (size_t)l * 1024 * DIN; ld_src = DIN; dst = (bf16_t*)(p.ws + WS_WBIN) + (size_t)l * DINP * 1024; ldd = 1024; }
    else { idx -= 21760; const int l = idx / 512, rem = idx % 512, tn = rem >> 5, tk = rem & 31; R0 = 64 * tn; kk0 = 64 * tk; srccol0 = R0;
        if (kk0 < 1024) { k0s = 1024 + kk0; scale = p.in[20] + l * 1024 + kk0; } else k0s = kk0 - 1024;
        src = p.in[21] + (size_t)l * 2048 * 1024; ld_src = 1024; dst = (bf16_t*)(p.ws + WS_WBOUT) + (size_t)l * 1024 * 2048; ldd = 2048; }
    bf16_t* tile = (bf16_t*)smem;
#pragma unroll
    for (int i = 0; i < 2; ++i) {
        const int k = (tid >> 4) + 32 * i, n4 = (tid & 15) * 4;
        f32x4 v = {0.f, 0.f, 0.f, 0.f};
        if (srccol0 + n4 < ncol) v = *(const f32x4*)(src + (size_t)(k0s + k) * ld_src + srccol0 + n4);
        const float s = scale ? scale[k] : 1.f;
        const unsigned w0 = pk2(v[0] * s, v[1] * s), w1 = pk2(v[2] * s, v[3] * s);
        tile[(n4 + 0) * 72 + k] = (bf16_t)(w0 & 0xffffu); tile[(n4 + 1) * 72 + k] = (bf16_t)(w0 >> 16);
        tile[(n4 + 2) * 72 + k] = (bf16_t)(w1 & 0xffffu); tile[(n4 + 3) * 72 + k] = (bf16_t)(w1 >> 16);
    }
    __syncthreads();
    { const int n = tid >> 3, k8 = (tid & 7) * 8; const u32x4 w = *(const u32x4*)(tile + n * 72 + k8); *(u32x4*)(dst + (size_t)(R0 + n) * ldd + kk0 + k8) = w; }
    __syncthreads();
}
__device__ __forceinline__ void phase0(const Params& p, unsigned char* smem, int tid, int wid, int lane) {
    { bf16_t* wm = (bf16_t*)(p.ws + WS_WM); const float* gw = p.in[13];
      for (int i = blockIdx.x * 512 + tid; i < 4 * 8 * 128 * 128; i += gridDim.x * 512) { const int s = i & 127, t = (i >> 7) & 127; const unsigned w = pk2(gw[i], 0.f); wm[i] = s <= t ? (bf16_t)(w & 0xffffu) : (bf16_t)0; } }
    for (int u = blockIdx.x; u < 152 + 23808; u += gridDim.x) { if (u < 152) p0_gemv(p, u, wid, lane); else p0_cvt(p, u - 152, smem, tid); }
}

template <bool FINAL> __device__ __forceinline__ void norm_phase(const Params& p, int l, int j, bool first, int wid, int lane) {
    const float* g = FINAL ? p.in[22] : p.in[8] + (l * 3 + j) * 1024;
    const float* modl = FINAL ? (const float*)(p.ws + WS_MODF) : (const float*)(p.ws + WS_MOD) + (size_t)l * 24 * 9216 + (3 * j) * 1024;
    const int mstride = FINAL ? 2048 : 9216;
    bf16_t* hn = (bf16_t*)(p.ws + WS_A2);
    const int rows = FINAL ? MV : MPAD;
    for (int row = blockIdx.x * 8 + wid; row < rows; row += gridDim.x * 8) {
        if (!FINAL && row >= MV) {
#pragma unroll
            for (int i = 0; i < 4; ++i) *(u32x2*)(hn + (size_t)row * DM + lane * 4 + 256 * i) = (u32x2){0u, 0u};
            continue;
        }
        const float* xr = first ? (row < MP ? p.in[0] + (size_t)row * DM : p.in[1] + (size_t)(row - MP) * DM) : p.out + (size_t)row * DM;
        f32x4 v[4]; float ss = 0.f;
#pragma unroll
        for (int i = 0; i < 4; ++i) { v[i] = *(const f32x4*)(xr + lane * 4 + 256 * i); ss += v[i][0] * v[i][0] + v[i][1] * v[i][1] + v[i][2] * v[i][2] + v[i][3] * v[i][3]; }
#pragma unroll
        for (int o = 32; o > 0; o >>= 1) ss += __shfl_xor(ss, o);
        const float rinv = rsqrtf(ss * (1.f / 1024.f) + 1e-6f);
        const float* sh = modl + (size_t)modrow(row) * mstride; const float* sc = sh + 1024;
#pragma unroll
        for (int i = 0; i < 4; ++i) {
            const int c = lane * 4 + 256 * i;
            const f32x4 gg = *(const f32x4*)(g + c), s4 = *(const f32x4*)(sc + c), h4 = *(const f32x4*)(sh + c);
            const f32x4 o = (v[i] * rinv * gg) * (1.f + s4) + h4;
            if (FINAL) *(f32x4*)(p.out + (size_t)row * DM + c) = o;
            else { *(u32x2*)(hn + (size_t)row * DM + c) = (u32x2){pk2(o[0], o[1]), pk2(o[2], o[3])}; if (first) *(f32x4*)(p.out + (size_t)row * DM + c) = v[i]; }
        }
    }
}

__device__ __forceinline__ void ld8(const bf16_t* q, float (&o)[8]) { const u32x4 w = *(const u32x4*)q; o[0] = bflo(w.x); o[1] = bfhi(w.x); o[2] = bflo(w.y); o[3] = bfhi(w.y); o[4] = bflo(w.z); o[5] = bfhi(w.z); o[6] = bflo(w.w); o[7] = bfhi(w.w); }
__device__ __forceinline__ void conv_unit(const Params& p, int l, int cu, int tid) {
    if (tid >= 384) return;
    int R0, nrows, sb = 0, ch = 0, b = 0; const bool sample = cu >= 512;
    if (!sample) { b = cu >> 5; ch = cu & 31; R0 = b * 2048 + 64 * ch; nrows = 64; } else { sb = cu - 512; R0 = MP + 16 * sb; nrows = 16; }
    const int cgi = tid % 192, half = tid / 192, c0 = cgi * 8, nr = nrows >> 1, t0 = half * nr;
    const bf16_t* proj = (const bf16_t*)(p.ws + WS_PROJ);
    bf16_t* a2 = (bf16_t*)(p.ws + WS_A2); bf16_t* bc = (bf16_t*)(p.ws + WS_BC);
    float w[4][8], bs[8], r0[8], r1[8], r2[8], cur[8];
#pragma unroll
    for (int k = 0; k < 4; ++k)
#pragma unroll
        for (int e = 0; e < 8; ++e) w[k][e] = p.in[15][(size_t)(l * 4 + k) * 1536 + c0 + e];
#pragma unroll
    for (int e = 0; e < 8; ++e) bs[e] = p.in[16][l * 1536 + c0 + e];
#pragma unroll
    for (int hh = 0; hh < 3; ++hh) {
        const int t = t0 - 3 + hh; float tmp[8];
        if (t >= 0 || (!sample && ch > 0)) ld8(proj + (size_t)(R0 + t) * PROJW + 3072 + c0, tmp);
        else if (sample) {
#pragma unroll
            for (int e = 0; e < 8; ++e) tmp[e] = p.in[3][(size_t)((l * 8 + sb) * 3 + (3 + t)) * 1536 + c0 + e];
        } else {
#pragma unroll
            for (int e = 0; e < 8; ++e) tmp[e] = 0.f;
        }
#pragma unroll
        for (int e = 0; e < 8; ++e) { if (hh == 0) r0[e] = tmp[e]; else if (hh == 1) r1[e] = tmp[e]; else r2[e] = tmp[e]; }
    }
    for (int t = t0; t < t0 + nr; ++t) {
        ld8(proj + (size_t)(R0 + t) * PROJW + 3072 + c0, cur);
        float y[8];
#pragma unroll
        for (int e = 0; e < 8; ++e) { const float a = bs[e] + w[0][e] * r0[e] + w[1][e] * r1[e] + w[2][e] * r2[e] + w[3][e] * cur[e]; y[e] = silu_f(a); }
        const u32x4 o = {pk2(y[0], y[1]), pk2(y[2], y[3]), pk2(y[4], y[5]), pk2(y[6], y[7])};
        if (c0 < 1024) *(u32x4*)(a2 + (size_t)(R0 + t) * 2048 + c0) = o; else *(u32x4*)(bc + (size_t)(R0 + t) * 512 + (c0 - 1024)) = o;
        int k = -1;
        if (!sample) { if (ch == 31 && t >= 61) k = t - 61; } else if (t >= 13) k = t - 13;
        if (k >= 0) { float* op = sample ? p.out + O_CONVS + (size_t)((l * 8 + sb) * 3 + k) * 1536 + c0 : p.out + O_CONVP + (size_t)((l * 16 + b) * 3 + k) * 1536 + c0;
            *(f32x4*)op = (f32x4){cur[0], cur[1], cur[2], cur[3]}; *(f32x4*)(op + 4) = (f32x4){cur[4], cur[5], cur[6], cur[7]}; }
#pragma unroll
        for (int e = 0; e < 8; ++e) { r0[e] = r1[e]; r1[e] = r2[e]; r2[e] = cur[e]; }
    }
}
__device__ __forceinline__ void gmlp_unit(const Params& p, int l, int gu, unsigned char* smem, int tid, int wid, int lane) {
    int R0, nrows, h, sb = 0; const bool sample = gu >= 2048;
    if (!sample) { const int b = gu >> 7, rem = gu & 127; h = rem & 7; R0 = b * 2048 + 128 * (rem >> 3); nrows = 128; } else { const int s = gu - 2048; sb = s >> 3; h = s & 7; R0 = MP + 16 * sb; nrows = 16; }
    bf16_t* vnT = (bf16_t*)smem;
    const bf16_t* proj = (const bf16_t*)(p.ws + WS_PROJ);
    {
        const int i = tid >> 2, q = tid & 3, d0 = q * 32;
        if (i < nrows) {
            float v[32];
#pragma unroll
            for (int c4 = 0; c4 < 4; ++c4) { float t8[8]; ld8(proj + (size_t)(R0 + i) * PROJW + 1024 + h * 128 + d0 + 8 * c4, t8);
#pragma unroll
                for (int e = 0; e < 8; ++e) v[8 * c4 + e] = gelu_t(t8[e]); }
            float s = 0.f;
#pragma unroll
            for (int e = 0; e < 32; ++e) s += v[e];
            s += __shfl_xor(s, 1); s += __shfl_xor(s, 2);
            const float mu = s * (1.f / 128.f);
            float q2 = 0.f;
#pragma unroll
            for (int e = 0; e < 32; ++e) { v[e] -= mu; q2 += v[e] * v[e]; }
            q2 += __shfl_xor(q2, 1); q2 += __shfl_xor(q2, 2);
            const float rs = rsqrtf(q2 * (1.f / 128.f) + 1e-6f);
            const float* ng = p.in[12] + l * 1024 + h * 128 + d0;
#pragma unroll
            for (int e = 0; e < 32; ++e) v[e] = v[e] * rs * ng[e];
#pragma unroll
            for (int e = 0; e < 32; e += 2) { const unsigned w = pk2(v[e], v[e + 1]); vnT[(d0 + e) * 136 + i] = (bf16_t)(w & 0xffffu); vnT[(d0 + e + 1) * 136 + i] = (bf16_t)(w >> 16); }
            if (sample) { float* gv = p.out + O_GMV + (size_t)((l * 8 + sb) * 16 + i) * 1024 + h * 128 + d0;
#pragma unroll
                for (int e = 0; e < 32; e += 4) *(f32x4*)(gv + e) = (f32x4){v[e], v[e + 1], v[e + 2], v[e + 3]}; }
        } else if (i < 32) {
#pragma unroll
            for (int e = 0; e < 32; ++e) vnT[(d0 + e) * 136 + i] = (bf16_t)0;
        }
    }
    __syncthreads();
    if (16 * wid < nrows) {
        const int fr = lane & 15, fq = lane >> 4, tt = 16 * wid, nk = ((tt + 15) >> 5) + 1;
        f32x4 acc[8];
#pragma unroll
        for (int d = 0; d < 8; ++d) acc[d] = (f32x4){0.f, 0.f, 0.f, 0.f};
        const bf16_t* wm = (const bf16_t*)(p.ws + WS_WM) + (size_t)((l * 8 + h) * 128 + tt + fr) * 128 + 8 * fq;
        for (int kk = 0; kk < nk; ++kk) {
            const bf16x8 bfr = *(const bf16x8*)(wm + 32 * kk);
#pragma unroll
            for (int d = 0; d < 8; ++d) { const bf16x8 afr = *(const bf16x8*)(vnT + (16 * d + fr) * 136 + 32 * kk + 8 * fq); acc[d] = __builtin_amdgcn_mfma_f32_16x16x32_bf16(afr, bfr, acc[d], 0, 0, 0); }
        }
        const int t = tt + fr; const float bias = p.in[14][(l * 8 + h) * 128 + t];
        bf16_t* a2 = (bf16_t*)(p.ws + WS_A2);
#pragma unroll
        for (int d = 0; d < 8; ++d) {
            const int dcol = h * 128 + 16 * d + 4 * fq;
            const u32x2 uw = *(const u32x2*)(proj + (size_t)(R0 + t) * PROJW + dcol);
            const float o0 = gelu_t(bflo(uw.x)) * (acc[d][0] + bias), o1 = gelu_t(bfhi(uw.x)) * (acc[d][1] + bias), o2 = gelu_t(bflo(uw.y)) * (acc[d][2] + bias), o3 = gelu_t(bfhi(uw.y)) * (acc[d][3] + bias);
            *(u32x2*)(a2 + (size_t)(R0 + t) * 2048 + 1024 + dcol) = (u32x2){pk2(o0, o1), pk2(o2, o3)};
        }
    }
    __syncthreads();
}

__device__ __forceinline__ void ssd_unit(const Params& p, int l, int su, unsigned char* smem, int tid, int wid, int lane) {
    int RB, nch, nL, h; const float* h0 = nullptr; float* hout;
    if (su < 256) { const int b = su >> 4; h = su & 15; RB = b * 2048; nch = 32; nL = 64; hout = p.out + O_SSMP + (size_t)((l * 16 + b) * 16 + h) * 8192; }
    else { const int s = su - 256, sb = s >> 4; h = s & 15; RB = MP + 16 * sb; nch = 1; nL = 16; h0 = p.in[2] + (size_t)((l * 8 + sb) * 16 + h) * 8192; hout = p.out + O_SSMS + (size_t)((l * 8 + sb) * 16 + h) * 8192; }
    const int g = h >> 3, fr = lane & 15, fq = lane >> 4;
    bf16_t* Cs = (bf16_t*)smem; bf16_t* Bs = Cs + 64 * 136; bf16_t* Hb = Bs + 64 * 136; bf16_t* BT = Hb + 64 * 136; bf16_t* XT = BT + 128 * 72; bf16_t* XdT = XT + 64 * 72; bf16_t* Gs = XdT + 64 * 72;
    bf16_t* Zs = Gs + 64 * 72; bf16_t* Xs = Zs + 64 * 72; float* acs = (float*)(Xs + 64 * 72); float* dts = acs + 64; float* ssq2 = dts + 64;
    const bf16_t* proj = (const bf16_t*)(p.ws + WS_PROJ); const bf16_t* bc = (const bf16_t*)(p.ws + WS_BC); bf16_t* a2 = (bf16_t*)(p.ws + WS_A2);
    const float* dtraw = (const float*)(p.ws + WS_DT); float* ssq = (float*)(p.ws + WS_SSQ);
    const float dtb = p.in[17][l * 16 + h], aneg = -__expf(p.in[18][l * 16 + h]), dsk = p.in[19][l * 16 + h];
    f32x4 st[4];
#pragma unroll
    for (int pt = 0; pt < 4; ++pt) st[pt] = h0 ? *(const f32x4*)(h0 + (size_t)(16 * pt + fr) * 128 + 16 * wid + 4 * fq) : (f32x4){0.f, 0.f, 0.f, 0.f};
    u32x4 px, pz, pb[2], pc[2]; float pdt;
    const int xrow = tid >> 3, xseg = tid & 7;
#define SSD_LOAD(R0) do { const u32x4 z4 = {0u, 0u, 0u, 0u}; \
        px = xrow < nL ? *(const u32x4*)(a2 + (size_t)((R0) + xrow) * 2048 + h * 64 + xseg * 8) : z4; \
        pz = xrow < nL ? *(const u32x4*)(proj + (size_t)((R0) + xrow) * PROJW + 2048 + h * 64 + xseg * 8) : z4; \
        _Pragma("unroll") for (int i = 0; i < 2; ++i) { const int idx = tid + 512 * i, row = idx >> 4, seg = idx & 15; \
            pb[i] = row < nL ? *(const u32x4*)(bc + (size_t)((R0) + row) * 512 + g * 128 + seg * 8) : z4; \
            pc[i] = row < nL ? *(const u32x4*)(bc + (size_t)((R0) + row) * 512 + 256 + g * 128 + seg * 8) : z4; } \
        pdt = lane < nL ? dtraw[(size_t)((R0) + lane) * 16 + h] : 0.f; } while (0)
    SSD_LOAD(RB);
    for (int c = 0; c < nch; ++c) {
        const int R0 = RB + 64 * c;
        *(u32x4*)(Xs + xrow * 72 + xseg * 8) = px; *(u32x4*)(Zs + xrow * 72 + xseg * 8) = pz;
        { const unsigned w[4] = {px.x, px.y, px.z, px.w};
#pragma unroll
          for (int e = 0; e < 4; ++e) { XT[(xseg * 8 + 2 * e) * 72 + xrow] = (bf16_t)(w[e] & 0xffffu); XT[(xseg * 8 + 2 * e + 1) * 72 + xrow] = (bf16_t)(w[e] >> 16); } }
#pragma unroll
        for (int i = 0; i < 2; ++i) { const int idx = tid + 512 * i, row = idx >> 4, seg = idx & 15;
            *(u32x4*)(Bs + row * 136 + seg * 8) = pb[i]; *(u32x4*)(Cs + row * 136 + seg * 8) = pc[i];
            const unsigned w[4] = {pb[i].x, pb[i].y, pb[i].z, pb[i].w};
#pragma unroll
            for (int e = 0; e < 4; ++e) { BT[(seg * 8 + 2 * e) * 72 + row] = (bf16_t)(w[e] & 0xffffu); BT[(seg * 8 + 2 * e + 1) * 72 + row] = (bf16_t)(w[e] >> 16); } }
#pragma unroll
        for (int pt = 0; pt < 4; ++pt) *(u32x2*)(Hb + (16 * pt + fr) * 136 + 16 * wid + 4 * fq) = (u32x2){pk2(st[pt][0], st[pt][1]), pk2(st[pt][2], st[pt][3])};
        { const float dtv = lane < nL ? softplus_f(pdt + dtb) : 0.f; float ac = dtv * aneg;
#pragma unroll
          for (int o = 1; o < 64; o <<= 1) { const float t = __shfl_up(ac, o); if (lane >= o) ac += t; }
          if (wid == 0) { acs[lane] = ac; dts[lane] = dtv; } }
        if (c + 1 < nch) SSD_LOAD(R0 + 64);
        __syncthreads();
        const float acL = acs[63];
        { const int lt = wid >> 1;
#pragma unroll
          for (int q = 0; q < 2; ++q) { const int stl = 2 * (wid & 1) + q; const int lrow = 16 * lt + fr, s0 = 16 * stl + 4 * fq;
              u32x2 o = {0u, 0u};
              if (stl <= lt) {
                  f32x4 acc = {0.f, 0.f, 0.f, 0.f};
#pragma unroll
                  for (int kk = 0; kk < 4; ++kk) { const bf16x8 a = *(const bf16x8*)(Bs + (16 * stl + fr) * 136 + 32 * kk + 8 * fq), b = *(const bf16x8*)(Cs + (16 * lt + fr) * 136 + 32 * kk + 8 * fq); acc = __builtin_amdgcn_mfma_f32_16x16x32_bf16(a, b, acc, 0, 0, 0); }
                  const float al = acs[lrow]; const f32x4 as4 = *(const f32x4*)(acs + s0), dt4 = *(const f32x4*)(dts + s0);
                  float gg[4];
#pragma unroll
                  for (int r = 0; r < 4; ++r) gg[r] = (s0 + r <= lrow) ? acc[r] * __expf(al - as4[r]) * dt4[r] : 0.f;
                  o = (u32x2){pk2(gg[0], gg[1]), pk2(gg[2], gg[3])};
              }
              *(u32x2*)(Gs + lrow * 72 + s0) = o; } }
        { const int s8 = xseg * 8; float x8[8]; ld8(XT + xrow * 72 + s8, x8);
#pragma unroll
          for (int e = 0; e < 8; ++e) x8[e] *= __expf(acL - acs[s8 + e]) * dts[s8 + e];
          *(u32x4*)(XdT + xrow * 72 + s8) = (u32x4){pk2(x8[0], x8[1]), pk2(x8[2], x8[3]), pk2(x8[4], x8[5]), pk2(x8[6], x8[7])}; }
        __syncthreads();
        { const int lt = wid >> 1, lrow = 16 * lt + fr; const float el = __expf(acs[lrow]); float sq = 0.f;
#pragma unroll
          for (int q = 0; q < 2; ++q) { const int pt = 2 * (wid & 1) + q, p0 = 16 * pt + 4 * fq;
              f32x4 ad = {0.f, 0.f, 0.f, 0.f}, ao = {0.f, 0.f, 0.f, 0.f};
#pragma unroll
              for (int kk = 0; kk < 2; ++kk) { const bf16x8 a = *(const bf16x8*)(XT + (16 * pt + fr) * 72 + 32 * kk + 8 * fq), b = *(const bf16x8*)(Gs + lrow * 72 + 32 * kk + 8 * fq); ad = __builtin_amdgcn_mfma_f32_16x16x32_bf16(a, b, ad, 0, 0, 0); }
#pragma unroll
              for (int kk = 0; kk < 4; ++kk) { const bf16x8 a = *(const bf16x8*)(Hb + (16 * pt + fr) * 136 + 32 * kk + 8 * fq), b = *(const bf16x8*)(Cs + lrow * 136 + 32 * kk + 8 * fq); ao = __builtin_amdgcn_mfma_f32_16x16x32_bf16(a, b, ao, 0, 0, 0); }
              const u32x2 xw = *(const u32x2*)(Xs + lrow * 72 + p0), zw = *(const u32x2*)(Zs + lrow * 72 + p0);
              const float xv[4] = {bflo(xw.x), bfhi(xw.x), bflo(xw.y), bfhi(xw.y)}, zv[4] = {bflo(zw.x), bfhi(zw.x), bflo(zw.y), bfhi(zw.y)};
              float y[4];
#pragma unroll
              for (int r = 0; r < 4; ++r) { y[r] = (ad[r] + el * ao[r] + dsk * xv[r]) * silu_f(zv[r]); sq += y[r] * y[r]; }
              if (lrow < nL) *(u32x2*)(a2 + (size_t)(R0 + lrow) * 2048 + h * 64 + p0) = (u32x2){pk2(y[0], y[1]), pk2(y[2], y[3])}; }
          sq += __shfl_xor(sq, 16); sq += __shfl_xor(sq, 32);
          if (fq == 0) ssq2[lrow * 2 + (wid & 1)] = sq; }
        { const float eL = __expf(acL);
#pragma unroll
          for (int pt = 0; pt < 4; ++pt) { f32x4 acc = {0.f, 0.f, 0.f, 0.f};
#pragma unroll
              for (int kk = 0; kk < 2; ++kk) { const bf16x8 a = *(const bf16x8*)(BT + (16 * wid + fr) * 72 + 32 * kk + 8 * fq), b = *(const bf16x8*)(XdT + (16 * pt + fr) * 72 + 32 * kk + 8 * fq); acc = __builtin_amdgcn_mfma_f32_16x16x32_bf16(a, b, acc, 0, 0, 0); }
              st[pt] = eL * st[pt] + acc; } }
        __syncthreads();
        if (tid < nL) ssq[(size_t)(R0 + tid) * 16 + h] = ssq2[tid * 2] + ssq2[tid * 2 + 1];
    }
#undef SSD_LOAD
#pragma unroll
    for (int pt = 0; pt < 4; ++pt) *(f32x4*)(hout + (size_t)(16 * pt + fr) * 128 + 16 * wid + 4 * fq) = st[pt];
    __syncthreads();
}

__global__ void __launch_bounds__(512, 2) mk_fwd(Params p) {
    extern __shared__ __attribute__((aligned(16))) unsigned char smem[];
    cg::grid_group grid = cg::this_grid();
    for (int ph = p.ph_lo; ph < p.ph_hi; ++ph) {
        if (ph > p.ph_lo) grid.sync();
        int tid_raw = threadIdx.x; asm volatile("" : "+v"(tid_raw));
        const int tid = tid_raw, wid = __builtin_amdgcn_readfirstlane(tid >> 6), lane = tid & 63;
        if (ph == 0) {
#ifndef SKIP_P0
 phase0(p, smem, tid, wid, lane);
#endif
 continue; }
        if (ph == NPH - 1) {
#ifndef SKIP_NORM
 norm_phase<true>(p, 0, 0, false, wid, lane);
#endif
 continue; }
        const int l = (ph - 1) / 11, s = (ph - 1) % 11;
        const float* modl = (const float*)(p.ws + WS_MOD) + (size_t)l * 24 * 9216;
        if (s == 0 || s == 3 || s == 8) {
#ifndef SKIP_NORM
 norm_phase<false>(p, l, s == 0 ? 0 : (s == 3 ? 1 : 2), ph == 1, wid, lane);
#endif
 }
        else if (s == 1 || s == 9) { const int j = s == 9;
            pg8::Gemm g{(const bf16_t*)(p.ws + WS_A2), (const bf16_t*)(p.ws + WS_WB1) + (size_t)(l * 2 + j) * 5632 * 1024, MPAD, 5632, 1024};
            pg8::StaticOrder S; S.init(g.M, g.N, (int)gridDim.x, (int)blockIdx.x);
            EpiSwiglu E{(bf16_t*)(p.ws + WS_PROJ), 0};
#ifndef SKIP_G1
            pg8::gemm_phase<EpiSwiglu, pg8::StaticOrder, false>((PG8_LAS unsigned char*)smem, g, S, E, nullptr);
#endif
 }
        else if (s == 2 || s == 10) { const int j = s == 10;
            pg8::Gemm g{(const bf16_t*)(p.ws + WS_PROJ), (const bf16_t*)(p.ws + WS_WB2) + (size_t)(l * 2 + j) * 1024 * DFF, MPAD, 1024, DFF};
            pg8::StaticOrder S; S.init(g.M, g.N, (int)gridDim.x, (int)blockIdx.x);
            EpiResid<false> E{p.out, modl + (j ? 8 : 2) * 1024, 0.5f, nullptr, 0};
#ifndef SKIP_G2
            pg8::gemm_phase<EpiResid<false>, pg8::StaticOrder, false>((PG8_LAS unsigned char*)smem, g, S, E, nullptr);
#endif
 }
        else if (s == 4) {
            pg8::Gemm g{(const bf16_t*)(p.ws + WS_A2), (const bf16_t*)(p.ws + WS_WBIN) + (size_t)l * DINP * 1024, MPAD, DINP, 1024};
            pg8::StaticOrder S; S.init(g.M, g.N, (int)gridDim.x, (int)blockIdx.x);
            EpiProj E{(bf16_t*)(p.ws + WS_PROJ), (float*)(p.ws + WS_DT), 0};
#ifndef SKIP_GIN
            pg8::gemm_phase<EpiProj, pg8::StaticOrder, false>((PG8_LAS unsigned char*)smem, g, S, E, nullptr);
#endif
 }
        else if (s == 5) { for (int u = blockIdx.x; u < 2112 + 520; u += gridDim.x) {
#ifndef SKIP_MIXA
 if (u < 2112) gmlp_unit(p, l, u, smem, tid, wid, lane); else conv_unit(p, l, u - 2112, tid);
#endif
 } }
        else if (s == 6) { for (int u = blockIdx.x; u < 384; u += gridDim.x) {
#ifndef SKIP_SSD
 ssd_unit(p, l, u, smem, tid, wid, lane);
#endif
 } }
        else {
            pg8::Gemm g{(const bf16_t*)(p.ws + WS_A2), (const bf16_t*)(p.ws + WS_WBOUT) + (size_t)l * 1024 * 2048, MPAD, 1024, 2048};
            pg8::StaticOrder S; S.init(g.M, g.N, (int)gridDim.x, (int)blockIdx.x);
            float* rl = (float*)(smem + 131072);
            { const float* ssq = (const float*)(p.ws + WS_SSQ);
              for (int i = 0; i < 3; ++i) { pg8::Unit uu; if (!S.next(i, uu)) break;
                  if (tid < 256) { const f32x4* sp = (const f32x4*)(ssq + (size_t)(uu.pm * 256 + tid) * 16); const f32x4 s4 = sp[0] + sp[1] + sp[2] + sp[3];
                      rl[i * 256 + tid] = rsqrtf((s4[0] + s4[1] + s4[2] + s4[3]) * (1.f / 1024.f) + 1e-6f); } }
              __syncthreads(); }
            EpiResid<true> E{p.out, modl + 5 * 1024, 1.0f, rl, 16};
#ifndef SKIP_GOUT
            pg8::gemm_phase<EpiResid<true>, pg8::StaticOrder, false>((PG8_LAS unsigned char*)smem, g, S, E, nullptr);
#endif
 }
    }
}

extern "C" void kernel_launch(void* const* d_in, const int* in_sizes, int n_in, void* d_out, int out_size, void* d_ws, size_t ws_size, hipStream_t stream) {
    static int grid = 0;
    if (grid == 0) {
        if (n_in != 25 || ws_size < WS_END) { fprintf(stderr, "kernel_launch: unexpected n_in %d or workspace %zu < %zu\n", n_in, ws_size, (size_t)WS_END); grid = -1; return; }
        int dev = 0, cus = 0, per_cu = 0;
        hipGetDevice(&dev); hipDeviceGetAttribute(&cus, hipDeviceAttributeMultiprocessorCount, dev);
        if (hipFuncSetAttribute((const void*)mk_fwd, hipFuncAttributeMaxDynamicSharedMemorySize, LDS_BYTES) != hipSuccess) { fprintf(stderr, "kernel_launch: hipFuncSetAttribute failed\n"); grid = -1; return; }
        if (hipOccupancyMaxActiveBlocksPerMultiprocessor(&per_cu, (const void*)mk_fwd, 512, LDS_BYTES) != hipSuccess || per_cu < 1) { fprintf(stderr, "kernel_launch: occupancy query gave %d\n", per_cu); per_cu = 1; (void)hipGetLastError(); }
        grid = cus * (per_cu > 1 ? 1 : per_cu);
    }
    if (grid < 0) return;
    Params p{};
    for (int i = 0; i < 25; ++i) p.in[i] = (const float*)d_in[i];
    p.out = (float*)d_out; p.ws = (unsigned char*)d_ws;
#if MK_MULTI
    for (int ph = 0; ph < NPH; ++ph) { p.ph_lo = ph; p.ph_hi = ph + 1; hipLaunchKernelGGL(mk_fwd, dim3(grid), dim3(512), LDS_BYTES, stream, p); }
#else
    p.ph_lo = 0; p.ph_hi = NPH;
    void* args[] = {&p};
    const hipError_t e = hipLaunchCooperativeKernel((const void*)mk_fwd, dim3(grid), dim3(512), args, LDS_BYTES, stream);
    if (e != hipSuccess) fprintf(stderr, "kernel_launch: cooperative launch failed: %s (grid %d)\n", hipGetErrorString(e), grid);
#endif
}
```

```cpp
#include <hip/hip_runtime.h>
#include <hip/hip_cooperative_groups.h>
#include <cstdio>
namespace cg = cooperative_groups;

#ifndef MK_MULTI
#define MK_MULTI 0
#endif

typedef unsigned short bf16_t;
typedef short bf16x8 __attribute__((ext_vector_type(8)));
typedef float f32x4 __attribute__((ext_vector_type(4)));
typedef float f32x16 __attribute__((ext_vector_type(16)));
typedef unsigned u32x4 __attribute__((ext_vector_type(4)));
typedef unsigned u32x2 __attribute__((ext_vector_type(2)));

constexpr int DM = 1024, MP = 32768  , MV = 32896  , MPAD = 33024  ;
constexpr int DFF = 2816, DIN = 4624, DINP = 4864, PROJW = 4608, NPH = 46;
constexpr int LDS_BYTES = 131072 + 3072 + 16;
constexpr size_t O_YS = 33554432, O_SSMP = 33685504, O_CONVP = 42074112, O_SSMS = 42369024, O_CONVS = 46563328, O_GMV = 46710784;
constexpr size_t WS_WB1 = 0;
constexpr size_t WS_WB2 = WS_WB1 + (size_t)8 * 5632 * 1024 * 2;
constexpr size_t WS_WBIN = WS_WB2 + (size_t)8 * 1024 * 2816 * 2;
constexpr size_t WS_WBOUT = WS_WBIN + (size_t)4 * DINP * 1024 * 2;
constexpr size_t WS_WM = WS_WBOUT + (size_t)4 * 1024 * 2048 * 2;
constexpr size_t WS_MOD = WS_WM + (size_t)4 * 8 * 128 * 128 * 2;
constexpr size_t WS_MODF = WS_MOD + (size_t)4 * 24 * 9216 * 4;
constexpr size_t WS_PROJ = WS_MODF + (size_t)24 * 2048 * 4;
constexpr size_t WS_DT = WS_PROJ + (size_t)MPAD * PROJW * 2;
constexpr size_t WS_BC = WS_DT + (size_t)MPAD * 16 * 4;
constexpr size_t WS_A2 = WS_BC + (size_t)MPAD * 512 * 2;
constexpr size_t WS_SSQ = WS_A2 + (size_t)MPAD * 2048 * 2;
constexpr size_t WS_BAR = WS_SSQ + (size_t)MPAD * 16 * 4;
constexpr size_t WS_END = WS_BAR + 16384;

struct Params { const float* in[25]; float* out; unsigned char* ws; int ph_lo, ph_hi; };

__device__ __forceinline__ float silu_f(float x) { return x * __builtin_amdgcn_rcpf(1.f + __builtin_amdgcn_exp2f(-1.4426950408889634f * x)); }
__device__ __forceinline__ float gelu_t(float x) { const float t = x * x; const float u = x * (-2.3022082f - 0.1029432f * t); return x * __builtin_amdgcn_rcpf(1.f + __builtin_amdgcn_exp2f(u)); }
__device__ __forceinline__ float softplus_f(float x) { return fmaxf(x, 0.f) + __logf(1.f + __expf(-fabsf(x))); }
__device__ __forceinline__ float bflo(unsigned w) { return __uint_as_float(w << 16); }
__device__ __forceinline__ float bfhi(unsigned w) { return __uint_as_float(w & 0xffff0000u); }
__device__ __forceinline__ unsigned pk2(float lo, float hi) { unsigned r; asm volatile("v_cvt_pk_bf16_f32 %0, %1, %2" : "=v"(r) : "v"(lo), "v"(hi)); return r; }
__device__ __forceinline__ int modrow(int row) { int r = row < MP ? (row >> 11) : 16 + ((row - MP) >> 4); return r > 23 ? 23 : r; }

__device__ __forceinline__ float wave_sum(float v) {
#define DPP_ADDV(ctrl, rmask) v += __int_as_float(__builtin_amdgcn_update_dpp(0, __float_as_int(v), ctrl, rmask, 0xf, true))
    DPP_ADDV(0x111, 0xf); DPP_ADDV(0x112, 0xf); DPP_ADDV(0x114, 0xf); DPP_ADDV(0x118, 0xf); DPP_ADDV(0x142, 0xa); DPP_ADDV(0x143, 0xc);
#undef DPP_ADDV
    return __int_as_float(__builtin_amdgcn_readlane(__float_as_int(v), 63));
}
__device__ __forceinline__ float quad_sum(float v) {
    v += __int_as_float(__builtin_amdgcn_update_dpp(0, __float_as_int(v), 0xB1, 0xf, 0xf, true));
    v += __int_as_float(__builtin_amdgcn_update_dpp(0, __float_as_int(v), 0x4E, 0xf, 0xf, true));
    return v;
}
namespace pg8 {
#define PG8_LAS __attribute__((address_space(3)))
typedef unsigned short bf16_t;
typedef short bf16x8 __attribute__((ext_vector_type(8)));
typedef float f32x4 __attribute__((ext_vector_type(4)));
typedef unsigned u32x4 __attribute__((ext_vector_type(4)));
constexpr int BM = 256, BK = 64, HALF = 128, HTB = HALF * BK * 2  , STAGE_BYTES = 8 * HTB, NXCD = 8, WGM = 8;

__host__ __device__ __forceinline__ int lds_byte(int r, int c) { const int st = (r >> 4) * 2 + (c >> 5), rr = r & 15, cc = c & 31, ob = rr * 64 + cc * 2; return st * 1024 + (ob ^ (((ob >> 9) & 1) << 5)); }
__host__ __device__ __forceinline__ void stage_rc(int b, int& R, int& C) { const int st = b / 1024, sb = b % 1024, swz = sb ^ (((sb >> 9) & 1) << 5); R = (st >> 1) * 16 + swz / 64; C = (st & 1) * 32 + (swz % 64) / 2; }
__host__ __device__ __forceinline__ int perm32(int rho) { const int n = rho >> 4, i = rho & 15; return 8 * (i >> 2) + 4 * n + (i & 3); }
struct Unit { int pm, pn; };
struct Gemm { const bf16_t* A; const bf16_t* Bt; int M, N, K; };
struct StaticOrder {
    int nM, nN, nwg, G, c;
    __host__ __device__ void init(int M, int N, int G_, int c_) { nM = M / BM; nN = N / BM; nwg = nM * nN; G = G_; c = c_; }
    __host__ __device__ bool next(int i, Unit& u) const {
        const long L = (long)i * G + c; if (L >= nwg) return false;
        int wgid = (int)L; { const int q = nwg / NXCD, r = nwg % NXCD, xcd = wgid % NXCD, off = wgid / NXCD; wgid = (xcd < r ? xcd * (q + 1) : r * (q + 1) + (xcd - r) * q) + off; }
        const int nig = WGM * nN, gid = wgid / nig, fm = gid * WGM, gsz = (nM - fm) < WGM ? (nM - fm) : WGM;
        u.pm = fm + ((wgid % nig) % gsz); u.pn = (wgid % nig) / gsz; return true;
    }
    __device__ __forceinline__ void a_ready(const Unit&) const {}
    __device__ __forceinline__ void done(const Unit&) const {}
};
__device__ __forceinline__ unsigned cvt_pk_bf16(float lo, float hi) { unsigned r; asm volatile("v_cvt_pk_bf16_f32 %0, %1, %2" : "=v"(r) : "v"(lo), "v"(hi)); return r; }
typedef float f32x2 __attribute__((ext_vector_type(2)));
template <class Epi, class Sched, bool STAMP = false>
__device__ __forceinline__ void gemm_phase(PG8_LAS unsigned char* lds, const Gemm g, const Sched& S, const Epi& E, unsigned long long* stamps) {
    int tid_raw = threadIdx.x; asm volatile("" : "+v"(tid_raw));
    const int tid = tid_raw, wid = __builtin_amdgcn_readfirstlane(tid >> 6), lane = tid & 63, wr = wid >> 2, wc = wid & 3, fr = lane & 15, fq = lane >> 4;
    const int K = g.K, nt = K / BK;
    int ts_lo = 0, ts_hi = 0, nts = 0; const unsigned long long rt_entry = STAMP ? (unsigned long long)wall_clock64() : 0ull;
#define PG8_STAMP() do { if (STAMP && wid == 0 && nts < 64) { const unsigned long long _c = (unsigned long long)clock64(); \
        ts_lo = (lane == nts) ? (int)(unsigned)_c : ts_lo; ts_hi = (lane == nts) ? (int)(unsigned)(_c >> 32) : ts_hi; ++nts; } } while (0)
    PG8_STAMP();
    unsigned voffA[2], voffB[2];
#pragma unroll
    for (int i = 0; i < 2; ++i) { int R, C; stage_rc(tid * 16 + i * 8192, R, C); const int Rb = Epi::PERM ? ((R & ~31) + perm32(R & 31)) : R;
        voffA[i] = (unsigned)(R * K + C) * 2u; voffB[i] = (unsigned)(Rb * K + C) * 2u; }
    const size_t kstep = (size_t)(BK * 2);
    const size_t hstep = (size_t)HALF * K * 2;
    const size_t tstep = 2 * hstep;
    const unsigned ldsw = (unsigned)wid * 1024u;
    const int aoff = lds_byte(wr * 64 + fr, fq * 8), boff = lds_byte(wc * 32 + fr, fq * 8);
#define PG8_SA(b, h) (((b) * 2 + (h)) * HTB)
#define PG8_SB(b, h) ((4 + (b) * 2 + (h)) * HTB)
#define PG8_STAGE(bufoff, gbase, voff) do { _Pragma("unroll") for (int _i = 0; _i < 2; ++_i) \
        __builtin_amdgcn_global_load_lds((const unsigned*)((const char*)(gbase) + (voff)[_i]), (PG8_LAS unsigned*)(lds + (bufoff) + ldsw + _i * 8192), 16, 0, 0); } while (0)
#define PG8_LDA(dst, b, h) do { _Pragma("unroll") for (int m = 0; m < 4; ++m) _Pragma("unroll") for (int k = 0; k < 2; ++k) dst[m][k] = *(const PG8_LAS bf16x8*)(lds + PG8_SA(b, h) + aoff + m * 2048 + k * 1024); } while (0)
#define PG8_LDB(dst, b, h) do { _Pragma("unroll") for (int n = 0; n < 2; ++n) _Pragma("unroll") for (int k = 0; k < 2; ++k) dst[n][k] = *(const PG8_LAS bf16x8*)(lds + PG8_SB(b, h) + boff + n * 2048 + k * 1024); } while (0)
#define PG8_MMA(ai, bj, At, Bt) do { __builtin_amdgcn_s_setprio(1); _Pragma("unroll") for (int m = 0; m < 4; ++m) _Pragma("unroll") for (int n = 0; n < 2; ++n) _Pragma("unroll") for (int k = 0; k < 2; ++k) \
        acc[ai][bj][m][n] = __builtin_amdgcn_mfma_f32_16x16x32_bf16(Bt[n][k], At[m][k], acc[ai][bj][m][n], 0, 0, 0); __builtin_amdgcn_s_setprio(0); } while (0)
#define PG8_WAIT_V(n) asm volatile("s_waitcnt vmcnt(" #n ")" ::: "memory")
#define PG8_WAIT_L(n) asm volatile("s_waitcnt lgkmcnt(" #n ")" ::: "memory")
#define PG8_BAR __builtin_amdgcn_s_barrier()
#define PG8_SCHED __builtin_amdgcn_sched_barrier(0)
    Unit cur, nxt; int ui = 0;
    if (!S.next(0, cur)) return;
    f32x4 acc[2][2][4][2];
#pragma unroll
    for (int a = 0; a < 2; ++a)
#pragma unroll
        for (int b = 0; b < 2; ++b)
#pragma unroll
            for (int m = 0; m < 4; ++m)
#pragma unroll
                for (int n = 0; n < 2; ++n) acc[a][b][m][n] = (f32x4){0.f, 0.f, 0.f, 0.f};
    bf16x8 At[4][2], B0[2][2], B1[2][2];
    const char* cA = (const char*)g.A + (size_t)cur.pm * tstep; const char* cB = (const char*)g.Bt + (size_t)cur.pn * tstep;
    S.a_ready(cur);
    PG8_STAGE(PG8_SB(0, 0), cB, voffB); PG8_STAGE(PG8_SA(0, 0), cA, voffA); PG8_STAGE(PG8_SB(0, 1), cB + hstep, voffB); PG8_STAGE(PG8_SA(0, 1), cA + hstep, voffA);
    if (wr == 1) PG8_BAR;
    PG8_WAIT_V(4); PG8_BAR;
    PG8_STAGE(PG8_SB(1, 0), cB + kstep, voffB); PG8_STAGE(PG8_SA(1, 0), cA + kstep, voffA); PG8_STAGE(PG8_SB(1, 1), cB + hstep + kstep, voffB);
    PG8_WAIT_V(6); PG8_BAR;
    PG8_STAMP();
    for (;;) {
        const bool has_next = S.next(ui + 1, nxt);
        const char* nA = has_next ? (const char*)g.A + (size_t)nxt.pm * tstep : cA; const char* nB = has_next ? (const char*)g.Bt + (size_t)nxt.pn * tstep : cB;
        for (int t = 0; t < nt; t += 2) {
            if constexpr (Epi::MIDK) { if (t == E.midk_t) E.mid(acc, ui, wr, wc, fr, fq); }
            const bool last = (t == nt - 2);
            const char* a1 = cA + (size_t)(t + 1) * kstep;
            const char* a2 = last ? nA : cA + (size_t)(t + 2) * kstep; const char* b2 = last ? nB : cB + (size_t)(t + 2) * kstep;
            const char* a3 = a2 + kstep; const char* b3 = b2 + kstep;
            if (last && has_next) S.a_ready(nxt);
            PG8_LDB(B0, 0, 0); PG8_SCHED; PG8_LDA(At, 0, 0); PG8_STAGE(PG8_SA(1, 1), a1 + hstep, voffA);
            PG8_WAIT_L(8); PG8_BAR; PG8_WAIT_L(0); PG8_MMA(0, 0, At, B0); PG8_BAR; PG8_SCHED;
            PG8_LDB(B1, 0, 1); PG8_STAGE(PG8_SB(0, 0), b2, voffB);
            PG8_BAR; PG8_WAIT_L(0); PG8_MMA(0, 1, At, B1); PG8_BAR;
            PG8_LDA(At, 0, 1); PG8_STAGE(PG8_SA(0, 0), a2, voffA);
            PG8_BAR; PG8_WAIT_L(0); PG8_MMA(1, 0, At, B0); PG8_BAR; PG8_SCHED;
            PG8_STAGE(PG8_SB(0, 1), b2 + hstep, voffB);
            PG8_WAIT_V(6); PG8_BAR; PG8_MMA(1, 1, At, B1); PG8_BAR;
            PG8_LDB(B0, 1, 0); PG8_SCHED; PG8_LDA(At, 1, 0); PG8_STAGE(PG8_SA(0, 1), a2 + hstep, voffA);
            PG8_WAIT_L(8); PG8_BAR; PG8_WAIT_L(0); PG8_MMA(0, 0, At, B0); PG8_BAR; PG8_SCHED;
            PG8_LDB(B1, 1, 1); PG8_STAGE(PG8_SB(1, 0), b3, voffB);
            PG8_BAR; PG8_WAIT_L(0); PG8_MMA(0, 1, At, B1); PG8_BAR;
            PG8_LDA(At, 1, 1); PG8_STAGE(PG8_SA(1, 0), a3, voffA);
            PG8_BAR; PG8_WAIT_L(0); PG8_MMA(1, 0, At, B0); PG8_BAR; PG8_SCHED;
            PG8_STAGE(PG8_SB(1, 1), b3 + hstep, voffB);
            PG8_WAIT_V(6); PG8_BAR; PG8_MMA(1, 1, At, B1); PG8_BAR;
        }
        PG8_STAMP();
        if constexpr (!Epi::AFTER_DRAIN) { E(acc, cur, wr, wc, fr, fq); S.done(cur); }
        PG8_STAMP();
        if (!has_next) break;
#pragma unroll
        for (int a = 0; a < 2; ++a)
#pragma unroll
            for (int b = 0; b < 2; ++b)
#pragma unroll
                for (int m = 0; m < 4; ++m)
#pragma unroll
                    for (int n = 0; n < 2; ++n) acc[a][b][m][n] = (f32x4){0.f, 0.f, 0.f, 0.f};
        cur = nxt; cA = nA; cB = nB; ++ui;
    }
    PG8_WAIT_V(0);
    if (wr == 0) PG8_BAR;
    PG8_BAR;
    if constexpr (Epi::AFTER_DRAIN) { E.fused(acc, cur, wr, wc, fr, fq, lds, wid, lane); S.done(cur); }
    PG8_STAMP();
    if (STAMP && wid == 0) { stamps[lane] = lane < nts ? (((unsigned long long)(unsigned)ts_hi << 32) | (unsigned)ts_lo) : 0ull;
        if (lane == 62) stamps[62] = rt_entry; if (lane == 63) stamps[63] = (unsigned long long)wall_clock64(); }
#undef PG8_STAMP
#undef PG8_SA
#undef PG8_SB
#undef PG8_STAGE
#undef PG8_LDA
#undef PG8_LDB
#undef PG8_MMA
#undef PG8_WAIT_V
#undef PG8_WAIT_L
#undef PG8_BAR
#undef PG8_SCHED
}
}
#define XB_TMO      128
#define XB_XCNT(j)  (256  + 64 * (j))
#define XB_XSUB(j)  (1280 + 64 * (j))
#define XB_XGEN(j)  (2304 + 64 * (j))
#define XB_TOP      3328
#define XB_TOPGEN   3392
#define XCD_BAR_WORDS 3456
#define XB_SPIN_CAP (1u << 18)
#define LAS __attribute__((address_space(3)))

__device__ __forceinline__ unsigned xb_ld(unsigned* p)              { return __hip_atomic_load(p, __ATOMIC_RELAXED, __HIP_MEMORY_SCOPE_AGENT); }
__device__ __forceinline__ unsigned xb_add(unsigned* p, unsigned v) { return __hip_atomic_fetch_add(p, v, __ATOMIC_RELAXED, __HIP_MEMORY_SCOPE_AGENT); }
__device__ __forceinline__ unsigned xb_xcc_id() { return (unsigned)__builtin_amdgcn_s_getreg((3 << 11) | 20) & 0xFu; }
#define XB_SPIN(cond, bar) do { unsigned _sp = 0; while (cond) { __builtin_amdgcn_s_sleep(1); \
    if ((++_sp & 255u) == 0u) { if (xb_ld(&(bar)[XB_TMO])) break; if (_sp > XB_SPIN_CAP) { atomicAdd(&(bar)[XB_TMO], 1u); break; } } } } while (0)

struct XcdBarrier {
    unsigned* bar; unsigned x;
    volatile LAS unsigned* st;
};

__device__ __forceinline__ XcdBarrier xcd_barrier_post(unsigned* bar, volatile LAS unsigned* st) {
    XcdBarrier b; b.bar = bar; b.x = xb_xcc_id(); b.st = st;
    if (threadIdx.x == 0) (void)xb_add(&bar[XB_XCNT(b.x)], 1u);
    return b;
}
__device__ __forceinline__ void xcd_barrier_complete(unsigned* bar, unsigned x, unsigned& nloc, unsigned& nx) {
    const unsigned G = gridDim.x * gridDim.y * gridDim.z;
    unsigned sum, cnt, mine, sp = 0u;
    for (;;) {
        sum = 0u; cnt = 0u; mine = 0u;
#pragma unroll
        for (unsigned j = 0; j < 16; ++j) { const unsigned c = xb_ld(&bar[XB_XCNT(j)]); sum += c; cnt += (c > 0u) ? 1u : 0u; mine = (j == x) ? c : mine; }
        if (sum == G) break;
        __builtin_amdgcn_s_sleep(1);
        if ((++sp & 255u) == 0u) { if (xb_ld(&bar[XB_TMO])) break; if (sp > XB_SPIN_CAP) { atomicAdd(&bar[XB_TMO], 1u); break; } }
    }
    nloc = mine > 0u ? mine : 1u; nx = cnt > 0u ? cnt : 1u;
}

__device__ __forceinline__ void xcd_barrier(const XcdBarrier& b) {
    asm volatile("s_waitcnt vmcnt(0)" ::: "memory");
    __syncthreads();
    if (threadIdx.x == 0) {
        unsigned* bar = b.bar;
        __builtin_amdgcn_s_waitcnt(0);
        unsigned nloc = b.st[0], nx = b.st[1];
        if (nloc == 0u) { xcd_barrier_complete(bar, b.x, nloc, nx); b.st[0] = nloc; b.st[1] = nx; }
        const unsigned old = xb_add(&bar[XB_XSUB(b.x)], 1u);
        const unsigned gen = old / nloc;
        if (old + 1u == (gen + 1u) * nloc) {
            __builtin_amdgcn_fence(__ATOMIC_RELEASE, "agent");
            asm volatile("s_waitcnt vmcnt(0)" ::: "memory");
            const unsigned og = xb_add(&bar[XB_TOP], 1u);
            const unsigned tg = og / nx;
            if (og + 1u == (tg + 1u) * nx) xb_add(&bar[XB_TOPGEN], 1u);
            else XB_SPIN(xb_ld(&bar[XB_TOPGEN]) == tg, bar);
            __builtin_amdgcn_fence(__ATOMIC_ACQUIRE, "agent");
            xb_add(&bar[XB_XGEN(b.x)], 1u);
            asm volatile("s_waitcnt vmcnt(0)" ::: "memory");
        } else {
            XB_SPIN(xb_ld(&bar[XB_XGEN(b.x)]) == gen, bar);
            __builtin_amdgcn_fence(__ATOMIC_ACQUIRE, "agent");
            asm volatile("s_waitcnt vmcnt(0)" ::: "memory");
        }
    }
    __syncthreads();
}
#define LDS_BARRIER() do { asm volatile("s_waitcnt lgkmcnt(0)" ::: "memory"); __builtin_amdgcn_s_barrier(); asm volatile("" ::: "memory"); } while (0)

struct EpiSwiglu {
    static constexpr bool PERM = true, AFTER_DRAIN = false, MIDK = false;
    bf16_t* H; int midk_t;
    __device__ __forceinline__ void operator()(const f32x4 (&acc)[2][2][4][2], const pg8::Unit& u, int wr, int wc, int fr, int fq) const {
        const int row0 = u.pm * 256 + wr * 64 + fr, col0 = u.pn * 128 + wc * 32 + 8 * fq;
#pragma unroll
        for (int ai = 0; ai < 2; ++ai)
#pragma unroll
            for (int m = 0; m < 4; ++m) {
                bf16_t* rowp = H + (size_t)(row0 + ai * 128 + m * 16) * DFF + col0;
                const f32x4 g0 = acc[ai][0][m][0], g1 = acc[ai][0][m][1], u0 = acc[ai][1][m][0], u1 = acc[ai][1][m][1];
                u32x4 w;
                w.x = pk2(silu_f(g0[0]) * u0[0], silu_f(g0[1]) * u0[1]); w.y = pk2(silu_f(g0[2]) * u0[2], silu_f(g0[3]) * u0[3]);
                w.z = pk2(silu_f(g1[0]) * u1[0], silu_f(g1[1]) * u1[1]); w.w = pk2(silu_f(g1[2]) * u1[2], silu_f(g1[3]) * u1[3]);
                *(u32x4*)rowp = w;
            }
    }
};
template <bool MID> struct EpiResid {
    static constexpr bool PERM = true, AFTER_DRAIN = false, MIDK = MID;
    bf16_t* X; const bf16_t* Xin; const float* gate; float coef; const float* rinv; int midk_t;
    __device__ __forceinline__ void operator()(const f32x4 (&acc)[2][2][4][2], const pg8::Unit& u, int wr, int wc, int fr, int fq) const {
        const int col0 = u.pn * 256 + wc * 32 + 8 * fq;
        const float* gp = gate + (size_t)(u.pm >> 3) * 9216 + col0;
        f32x4 gv[2][2];
#pragma unroll
        for (int bj = 0; bj < 2; ++bj)
#pragma unroll
            for (int n = 0; n < 2; ++n) gv[bj][n] = coef * *(const f32x4*)(gp + bj * 128 + 4 * n);
#pragma unroll
        for (int ai = 0; ai < 2; ++ai) {
            u32x4 xw[4][2];
#pragma unroll
            for (int m = 0; m < 4; ++m)
#pragma unroll
                for (int bj = 0; bj < 2; ++bj) xw[m][bj] = *(const u32x4*)(Xin + (size_t)(u.pm * 256 + ai * 128 + wr * 64 + m * 16 + fr) * DM + col0 + bj * 128);
#pragma unroll
            for (int m = 0; m < 4; ++m)
#pragma unroll
                for (int bj = 0; bj < 2; ++bj) { const u32x4 w = xw[m][bj]; const f32x4 a0 = gv[bj][0] * acc[ai][bj][m][0], a1 = gv[bj][1] * acc[ai][bj][m][1];
                    const u32x4 o = {pk2(bflo(w.x) + a0[0], bfhi(w.x) + a0[1]), pk2(bflo(w.y) + a0[2], bfhi(w.y) + a0[3]), pk2(bflo(w.z) + a1[0], bfhi(w.z) + a1[1]), pk2(bflo(w.w) + a1[2], bfhi(w.w) + a1[3])};
                    *(u32x4*)(X + (size_t)(u.pm * 256 + ai * 128 + wr * 64 + m * 16 + fr) * DM + col0 + bj * 128) = o; }
            asm volatile("" ::: "memory");
        }
    }
    __device__ __forceinline__ void mid(f32x4 (&acc)[2][2][4][2], int ui, int wr, int wc, int fr, int fq) const {
        const float* rl = rinv + ui * 256 + wr * 64 + fr;
#pragma unroll
        for (int ai = 0; ai < 2; ++ai)
#pragma unroll
            for (int m = 0; m < 4; ++m) {
                const float r = rl[ai * 128 + m * 16];
#pragma unroll
                for (int bj = 0; bj < 2; ++bj)
#pragma unroll
                    for (int n = 0; n < 2; ++n) acc[ai][bj][m][n] *= r;
            }
    }
};
struct EpiProj {
    static constexpr bool PERM = true, AFTER_DRAIN = false, MIDK = false;
    bf16_t* P; float* DT; int midk_t;
    __device__ __forceinline__ void operator()(const f32x4 (&acc)[2][2][4][2], const pg8::Unit& u, int wr, int wc, int fr, int fq) const {
        const int row0 = u.pm * 256 + wr * 64 + fr;
        {
            const int col0 = u.pn * 256 + wc * 32 + 8 * fq;
#pragma unroll
            for (int ai = 0; ai < 2; ++ai)
#pragma unroll
                for (int m = 0; m < 4; ++m) {
                    bf16_t* rowp = P + (size_t)(row0 + ai * 128 + m * 16) * PROJW + col0;
#pragma unroll
                    for (int bj = 0; bj < 2; ++bj) { const f32x4 v0 = acc[ai][bj][m][0], v1 = acc[ai][bj][m][1]; u32x4 w; w.x = pk2(v0[0], v0[1]); w.y = pk2(v0[2], v0[3]); w.z = pk2(v1[0], v1[1]); w.w = pk2(v1[2], v1[3]); *(u32x4*)(rowp + bj * 128) = w; }
                }
        }
    }
};


__device__ __forceinline__ f32x4 sg_dot(const bf16_t* A, int lda, int row0, const bf16_t* Bt, int ldb, int n0, int k0, int nk, int wid, int lane) {
    const int fr = lane & 15, fq = lane >> 4;
    const bf16_t* ap = A + (size_t)(row0 + 16 * wid + fr) * lda + k0 + 8 * fq; const bf16_t* bp = Bt + (size_t)(n0 + fr) * ldb + k0 + 8 * fq;
    f32x4 acc = {0.f, 0.f, 0.f, 0.f};
    for (int kb = 0; kb < nk; kb += 16) {
        bf16x8 a[16], bb[16];
#pragma unroll
        for (int j = 0; j < 16; ++j) if (kb + j < nk) { a[j] = *(const bf16x8*)(ap + 32 * (kb + j)); bb[j] = *(const bf16x8*)(bp + 32 * (kb + j)); }
#pragma unroll
        for (int j = 0; j < 16; ++j) if (kb + j < nk) acc = __builtin_amdgcn_mfma_f32_16x16x32_bf16(bb[j], a[j], acc, 0, 0, 0);
    }
    return acc;
}
__device__ __forceinline__ void sg_g1(const Params& p, int l, int j, int wid, int lane) {
    const bf16_t* A = (const bf16_t*)(p.ws + WS_A2); const bf16_t* Bt = (const bf16_t*)(p.ws + WS_WB1) + (size_t)(l * 2 + j) * 5632 * 1024; bf16_t* H = (bf16_t*)(p.ws + WS_PROJ);
    const int fr = lane & 15, fq = lane >> 4;
    for (int it = blockIdx.x; it < 176; it += gridDim.x) {
        const int c0 = 16 * it, rg = 256 * (c0 >> 7) + (c0 & 127);
        const f32x4 g = sg_dot(A, 1024, MP, Bt, 1024, rg, 0, 32, wid, lane), u = sg_dot(A, 1024, MP, Bt, 1024, rg + 128, 0, 32, wid, lane);
        *(u32x2*)(H + (size_t)(MP + 16 * wid + fr) * DFF + c0 + 4 * fq) = (u32x2){pk2(silu_f(g[0]) * u[0], silu_f(g[1]) * u[1]), pk2(silu_f(g[2]) * u[2], silu_f(g[3]) * u[3])};
    }
}
__device__ __forceinline__ void sg_resid(const Params& p, const bf16_t* A, int K, const bf16_t* Bt, const float* gate, float coef, const float* ssq, int wid, int lane) {
    const int fr = lane & 15, fq = lane >> 4, row = MP + 16 * wid + fr; const int kq = K >> 2;
    for (int it = blockIdx.x; it < 256; it += gridDim.x) {
        const int ct = it >> 2, ks = it & 3;
        f32x4 acc = sg_dot(A, K, MP, Bt, K, 16 * ct, ks * kq, kq >> 5, wid, lane);
        if (ssq && ks < 2) { const f32x4* sp = (const f32x4*)(ssq + (size_t)row * 16); const f32x4 s4 = sp[0] + sp[1] + sp[2] + sp[3]; acc *= rsqrtf((s4[0] + s4[1] + s4[2] + s4[3]) * (1.f / 1024.f) + 1e-6f); }
        const f32x4 gv = *(const f32x4*)(gate + (size_t)modrow(row) * 9216 + 16 * ct + 4 * fq);
        float* xp = p.out + (size_t)row * DM + 16 * ct + 4 * fq;
#pragma unroll
        for (int r = 0; r < 4; ++r) atomicAdd(xp + r, coef * gv[r] * acc[r]);
    }
}
__device__ __forceinline__ void sg_in(const Params& p, int l, int wid, int lane) {
    const bf16_t* A = (const bf16_t*)(p.ws + WS_A2); const bf16_t* Bt = (const bf16_t*)(p.ws + WS_WBIN) + (size_t)l * DINP * 1024; bf16_t* P = (bf16_t*)(p.ws + WS_PROJ); float* DT = (float*)(p.ws + WS_DT);
    const int fr = lane & 15, fq = lane >> 4;
    for (int it = blockIdx.x; it < 289 + 256; it += gridDim.x) {
        const int ct = it < 289 ? it : 288, row0 = it < 289 ? MP : 128 * (it - 289);
        const f32x4 acc = sg_dot(A, 1024, row0, Bt, 1024, 16 * ct, 0, 32, wid, lane);
        const int row = row0 + 16 * wid + fr;
        if (ct < 288) *(u32x2*)(P + (size_t)row * PROJW + 16 * ct + 4 * fq) = (u32x2){pk2(acc[0], acc[1]), pk2(acc[2], acc[3])};
        else *(f32x4*)(DT + (size_t)row * 16 + 4 * fq) = acc;
    }
}

__device__ __forceinline__ void p0_gemv(const Params& p, int u, unsigned char* smem, int tid, int wid, int lane) {
    const float* src; const float* bias; float* dst; int ld, n0;
    if (u < 288) { const int l = u / 72; n0 = (u % 72) * 128; src = p.in[6] + (size_t)l * 1024 * 9216; bias = p.in[7] + l * 9216; dst = (float*)(p.ws + WS_MOD) + (size_t)l * 24 * 9216; ld = 9216; }
    else { n0 = (u - 288) * 128; src = p.in[23]; bias = p.in[24]; dst = (float*)(p.ws + WS_MODF); ld = 2048; }
    const int i = lane & 31, kh = lane >> 5; const bool valid = i < 24;
    const float* cptr = (i < 16 ? p.in[4] + i * 1024 : p.in[5] + ((valid ? i : 16) - 16) * 1024) + wid * 128 + kh;
    const float* sp = src + (size_t)(wid * 128 + kh) * ld + n0 + 4 * i;
    f32x16 acc0, acc1, acc2, acc3;
    for (int r = 0; r < 16; ++r) { acc0[r] = 0.f; acc1[r] = 0.f; acc2[r] = 0.f; acc3[r] = 0.f; }
    for (int kb = 0; kb < 128; kb += 16) {
        f32x4 bw[8]; float cv[8];
#pragma unroll
        for (int j = 0; j < 8; ++j) { bw[j] = *(const f32x4*)(sp + (size_t)(kb + 2 * j) * ld); cv[j] = cptr[kb + 2 * j]; }
#pragma unroll
        for (int j = 0; j < 8; ++j) { const float a = valid ? silu_f(cv[j]) : 0.f;
            acc0 = __builtin_amdgcn_mfma_f32_32x32x2f32(a, bw[j][0], acc0, 0, 0, 0); acc1 = __builtin_amdgcn_mfma_f32_32x32x2f32(a, bw[j][1], acc1, 0, 0, 0);
            acc2 = __builtin_amdgcn_mfma_f32_32x32x2f32(a, bw[j][2], acc2, 0, 0, 0); acc3 = __builtin_amdgcn_mfma_f32_32x32x2f32(a, bw[j][3], acc3, 0, 0, 0); }
    }
    float* red = (float*)smem;
#pragma unroll
    for (int r = 0; r < 12; ++r) { float* q = red + ((wid * 4) * 12 + r) * 64 + lane; q[0] = acc0[r]; q[12 * 64] = acc1[r]; q[24 * 64] = acc2[r]; q[36 * 64] = acc3[r]; }
    LDS_BARRIER();
#pragma unroll
    for (int t = 0; t < 6; ++t) { const int idx = tid + 512 * t, c = idx / 768, r = (idx % 768) >> 6, ln = idx & 63;
        float s = 0.f;
#pragma unroll
        for (int w = 0; w < 8; ++w) s += red[((w * 4 + c) * 12 + r) * 64 + ln];
        const int row = (r & 3) + 8 * (r >> 2) + 4 * (ln >> 5), col = n0 + 4 * (ln & 31) + c;
        dst[(size_t)row * ld + col] = s + bias[col]; }
    LDS_BARRIER();
}
struct CvtUnit { const float* src; bf16_t* dst; const float* scale; const float* fallback; int ld_src, ldd, ncolrem; };
__device__ __forceinline__ CvtUnit p0_cvt_decode(const Params& p, int idx) {
    CvtUnit c; c.scale = nullptr; c.fallback = p.in[20]; c.ncolrem = 1 << 30; int R0, kk0, k0s, srccol0;
    if (idx < 5632) { const int m = idx / 704, rem = idx % 704, tn = rem >> 3, tk = rem & 7; R0 = 64 * tn; kk0 = 128 * tk; k0s = kk0;
        srccol0 = ((R0 >> 7) & 1) * DFF + 128 * (R0 >> 8) + (R0 & 127); c.src = p.in[9] + (size_t)m * 1024 * 5632; c.ld_src = 5632; c.dst = (bf16_t*)(p.ws + WS_WB1) + (size_t)m * 5632 * 1024; c.ldd = 1024; }
    else if (idx < 8448) { idx -= 5632; const int m = idx / 352, rem = idx % 352, tn = rem / 22, tk = rem % 22; R0 = 64 * tn; kk0 = 128 * tk; k0s = kk0; srccol0 = R0;
        c.src = p.in[10] + (size_t)m * DFF * 1024; c.ld_src = 1024; c.dst = (bf16_t*)(p.ws + WS_WB2) + (size_t)m * 1024 * DFF; c.ldd = DFF; }
    else if (idx < 10880) { idx -= 8448; const int l = idx / 608, rem = idx % 608, tn = rem >> 3, tk = rem & 7; R0 = 64 * tn; kk0 = 128 * tk; k0s = kk0; srccol0 = R0; c.ncolrem = DIN - srccol0;
        c.src = p.in[11] + (size_t)l * 1024 * DIN; c.ld_src = DIN; c.dst = (bf16_t*)(p.ws + WS_WBIN) + (size_t)l * DINP * 1024; c.ldd = 1024; }
    else { idx -= 10880; const int l = idx >> 8, rem = idx & 255, tn = rem >> 4, tk = rem & 15; R0 = 64 * tn; kk0 = 128 * tk; srccol0 = R0;
        if (kk0 < 1024) { k0s = 1024 + kk0; c.scale = p.in[20] + l * 1024 + kk0; } else k0s = kk0 - 1024;
        c.src = p.in[21] + (size_t)l * 2048 * 1024; c.ld_src = 1024; c.dst = (bf16_t*)(p.ws + WS_WBOUT) + (size_t)l * 1024 * 2048; c.ldd = 2048; }
    c.src += (size_t)k0s * c.ld_src + srccol0; c.dst += (size_t)R0 * c.ldd + kk0;
    return c;
}
__device__ __forceinline__ void p0_cvt_load(const CvtUnit& c, int wid, int lane, f32x4 (&v)[4], float (&sc)[2]) {
#pragma unroll
    for (int i = 0; i < 4; ++i) { const int gi = wid + 8 * (i & 1), k = lane + 64 * (i >> 1);
        v[i] = (4 * gi < c.ncolrem) ? *(const f32x4*)(c.src + (size_t)k * c.ld_src + 4 * gi) : (f32x4){0.f, 0.f, 0.f, 0.f}; }
    const float* sp = c.scale ? c.scale : c.fallback; const float s0 = sp[lane], s1 = sp[lane + 64];
    sc[0] = s0; sc[1] = s1;
}
__device__ __forceinline__ void phase0(const Params& p, unsigned char* smem, int tid, int wid, int lane) {
    { bf16_t* wm = (bf16_t*)(p.ws + WS_WM); const float* gw = p.in[13];
      for (int i = blockIdx.x * 512 + tid; i < 4 * 8 * 128 * 128; i += gridDim.x * 512) { const int s = i & 127, t = (i >> 7) & 127; const unsigned w = pk2(gw[i], 0.f); wm[i] = s <= t ? (bf16_t)(w & 0xffffu) : (bf16_t)0; } }
    for (int u = blockIdx.x; u < 304; u += gridDim.x) p0_gemv(p, u, smem, tid, wid, lane);
    bf16_t* tile = (bf16_t*)smem;
    int u = blockIdx.x; CvtUnit cu; f32x4 v[4]; float sc[2];
    bool hs = false;
    if (u < 11904) { cu = p0_cvt_decode(p, u); p0_cvt_load(cu, wid, lane, v, sc); hs = cu.scale != nullptr; }
    while (u < 11904) {
#pragma unroll
        for (int i = 0; i < 4; ++i) { const int gi = wid + 8 * (i & 1), k = lane + 64 * (i >> 1); const float s = hs ? sc[i >> 1] : 1.f;
            const unsigned w0 = pk2(v[i][0] * s, v[i][1] * s), w1 = pk2(v[i][2] * s, v[i][3] * s);
            tile[(4 * gi + 0) * 136 + k] = (bf16_t)(w0 & 0xffffu); tile[(4 * gi + 1) * 136 + k] = (bf16_t)(w0 >> 16);
            tile[(4 * gi + 2) * 136 + k] = (bf16_t)(w1 & 0xffffu); tile[(4 * gi + 3) * 136 + k] = (bf16_t)(w1 >> 16); }
        bf16_t* dst = cu.dst; const int ldd = cu.ldd;
        const int un = u + gridDim.x;
        if (un < 11904) { cu = p0_cvt_decode(p, un); p0_cvt_load(cu, wid, lane, v, sc); hs = cu.scale != nullptr; }
        LDS_BARRIER();
#pragma unroll
        for (int i = 0; i < 2; ++i) { const int id = tid + 512 * i, n = id >> 4, c8 = (id & 15) * 8; const u32x4 w = *(const u32x4*)(tile + n * 136 + c8); *(u32x4*)(dst + (size_t)n * ldd + c8) = w; }
        LDS_BARRIER();
        u = un;
    }
}

template <bool FINAL> __device__ __forceinline__ void norm_phase(const Params& p, int l, int j, bool first, const bf16_t* xsrc, bf16_t* xb, int wid, int lane) {
    const float* g = FINAL ? p.in[22] : p.in[8] + (l * 3 + j) * 1024;
    const float* modl = FINAL ? (const float*)(p.ws + WS_MODF) : (const float*)(p.ws + WS_MOD) + (size_t)l * 24 * 9216 + (3 * j) * 1024;
    const int mstride = FINAL ? 2048 : 9216;
    bf16_t* hn = (bf16_t*)(p.ws + WS_A2);
    for (int row0 = (blockIdx.x * 8 + wid) * 2; row0 < MV; row0 += gridDim.x * 16) {
        float v[2][16]; float ss[2];
        const bool f32src = first || row0 >= MP;
#pragma unroll
        for (int q = 0; q < 2; ++q) { const int row = row0 + q;
            if (f32src) { const float* xr = row >= MP ? (first ? p.in[1] + (size_t)(row - MP) * DM : p.out + (size_t)row * DM) : p.in[0] + (size_t)row * DM;
#pragma unroll
                for (int i = 0; i < 2; ++i) { const f32x4 a = *(const f32x4*)(xr + lane * 8 + 512 * i), c4 = *(const f32x4*)(xr + lane * 8 + 512 * i + 4);
                    v[q][8 * i + 0] = a[0]; v[q][8 * i + 1] = a[1]; v[q][8 * i + 2] = a[2]; v[q][8 * i + 3] = a[3]; v[q][8 * i + 4] = c4[0]; v[q][8 * i + 5] = c4[1]; v[q][8 * i + 6] = c4[2]; v[q][8 * i + 7] = c4[3]; }
            } else {
#pragma unroll
                for (int i = 0; i < 2; ++i) { const u32x4 w = *(const u32x4*)(xsrc + (size_t)row * DM + lane * 8 + 512 * i);
                    v[q][8 * i + 0] = bflo(w.x); v[q][8 * i + 1] = bfhi(w.x); v[q][8 * i + 2] = bflo(w.y); v[q][8 * i + 3] = bfhi(w.y); v[q][8 * i + 4] = bflo(w.z); v[q][8 * i + 5] = bfhi(w.z); v[q][8 * i + 6] = bflo(w.w); v[q][8 * i + 7] = bfhi(w.w); }
            } }
#pragma unroll
        for (int q = 0; q < 2; ++q) { float s = 0.f;
#pragma unroll
            for (int e = 0; e < 16; ++e) s += v[q][e] * v[q][e];
            ss[q] = wave_sum(s); }
#pragma unroll
        for (int q = 0; q < 2; ++q) { const int row = row0 + q;
            const float rinv = rsqrtf(ss[q] * (1.f / 1024.f) + 1e-6f);
            const float* sh = modl + (size_t)modrow(row) * mstride; const float* sc = sh + 1024;
#pragma unroll
            for (int i = 0; i < 2; ++i) {
                const int c = lane * 8 + 512 * i; float o[8];
#pragma unroll
                for (int hh = 0; hh < 2; ++hh) { const f32x4 gg = *(const f32x4*)(g + c + 4 * hh), s4 = *(const f32x4*)(sc + c + 4 * hh), h4 = *(const f32x4*)(sh + c + 4 * hh);
#pragma unroll
                    for (int e = 0; e < 4; ++e) o[4 * hh + e] = (v[q][8 * i + 4 * hh + e] * rinv * gg[e]) * (1.f + s4[e]) + h4[e]; }
                if (FINAL) { *(f32x4*)(p.out + (size_t)row * DM + c) = (f32x4){o[0], o[1], o[2], o[3]}; *(f32x4*)(p.out + (size_t)row * DM + c + 4) = (f32x4){o[4], o[5], o[6], o[7]}; }
                else { *(u32x4*)(hn + (size_t)row * DM + c) = (u32x4){pk2(o[0], o[1]), pk2(o[2], o[3]), pk2(o[4], o[5]), pk2(o[6], o[7])};
                    if (first) { if (row >= MP) { *(f32x4*)(p.out + (size_t)row * DM + c) = (f32x4){v[q][8 * i], v[q][8 * i + 1], v[q][8 * i + 2], v[q][8 * i + 3]}; *(f32x4*)(p.out + (size_t)row * DM + c + 4) = (f32x4){v[q][8 * i + 4], v[q][8 * i + 5], v[q][8 * i + 6], v[q][8 * i + 7]}; }
                                 else *(u32x4*)(xb + (size_t)row * DM + c) = (u32x4){pk2(v[q][8 * i], v[q][8 * i + 1]), pk2(v[q][8 * i + 2], v[q][8 * i + 3]), pk2(v[q][8 * i + 4], v[q][8 * i + 5]), pk2(v[q][8 * i + 6], v[q][8 * i + 7])}; } }
            } }
    }
}

__device__ __forceinline__ void ld8(const bf16_t* q, float (&o)[8]) { const u32x4 w = *(const u32x4*)q; o[0] = bflo(w.x); o[1] = bfhi(w.x); o[2] = bflo(w.y); o[3] = bfhi(w.y); o[4] = bflo(w.z); o[5] = bfhi(w.z); o[6] = bflo(w.w); o[7] = bfhi(w.w); }
__device__ __forceinline__ void conv_unit(const Params& p, int l, int cu, int tid) {
    if (tid >= 384) return;
    int R0, nrows, sb = 0, ch = 0, b = 0; const bool sample = cu >= 512;
    if (!sample) { b = cu >> 5; ch = cu & 31; R0 = b * 2048 + 64 * ch; nrows = 64; } else { sb = cu - 512; R0 = MP + 16 * sb; nrows = 16; }
    const int cgi = tid % 192, half = tid / 192, c0 = cgi * 8, nr = nrows >> 1, t0 = half * nr;
    const bf16_t* proj = (const bf16_t*)(p.ws + WS_PROJ);
    bf16_t* a2 = (bf16_t*)(p.ws + WS_A2); bf16_t* bc = (bf16_t*)(p.ws + WS_BC);
    float w[4][8], bs[8], r0[8], r1[8], r2[8], cur[8];
#pragma unroll
    for (int k = 0; k < 4; ++k)
#pragma unroll
        for (int e = 0; e < 8; ++e) w[k][e] = p.in[15][(size_t)(l * 4 + k) * 1536 + c0 + e];
#pragma unroll
    for (int e = 0; e < 8; ++e) bs[e] = p.in[16][l * 1536 + c0 + e];
#pragma unroll
    for (int hh = 0; hh < 3; ++hh) {
        const int t = t0 - 3 + hh; float tmp[8];
        if (t >= 0 || (!sample && ch > 0)) ld8(proj + (size_t)(R0 + t) * PROJW + 3072 + c0, tmp);
        else if (sample) {
#pragma unroll
            for (int e = 0; e < 8; ++e) tmp[e] = p.in[3][(size_t)((l * 8 + sb) * 3 + (3 + t)) * 1536 + c0 + e];
        } else {
#pragma unroll
            for (int e = 0; e < 8; ++e) tmp[e] = 0.f;
        }
#pragma unroll
        for (int e = 0; e < 8; ++e) { if (hh == 0) r0[e] = tmp[e]; else if (hh == 1) r1[e] = tmp[e]; else r2[e] = tmp[e]; }
    }
    u32x4 raw[4], rawn[4];
#pragma unroll
    for (int q = 0; q < 4; ++q) raw[q] = *(const u32x4*)(proj + (size_t)(R0 + t0 + q) * PROJW + 3072 + c0);
#pragma unroll 1
    for (int tb = t0; tb < t0 + nr; tb += 4) {
        if (tb + 4 < t0 + nr) {
#pragma unroll
            for (int q = 0; q < 4; ++q) rawn[q] = *(const u32x4*)(proj + (size_t)(R0 + tb + 4 + q) * PROJW + 3072 + c0);
        }
#pragma unroll
        for (int q = 0; q < 4; ++q) {
            const int t = tb + q; const u32x4 w4 = raw[q];
            cur[0] = bflo(w4.x); cur[1] = bfhi(w4.x); cur[2] = bflo(w4.y); cur[3] = bfhi(w4.y); cur[4] = bflo(w4.z); cur[5] = bfhi(w4.z); cur[6] = bflo(w4.w); cur[7] = bfhi(w4.w);
            float y[8];
#pragma unroll
            for (int e = 0; e < 8; ++e) { const float a = bs[e] + w[0][e] * r0[e] + w[1][e] * r1[e] + w[2][e] * r2[e] + w[3][e] * cur[e]; y[e] = silu_f(a); }
            const u32x4 o = {pk2(y[0], y[1]), pk2(y[2], y[3]), pk2(y[4], y[5]), pk2(y[6], y[7])};
            if (c0 < 1024) *(u32x4*)(a2 + (size_t)(R0 + t) * 2048 + c0) = o; else *(u32x4*)(bc + (size_t)(R0 + t) * 512 + (c0 - 1024)) = o;
            int k = -1;
            if (!sample) { if (ch == 31 && t >= 61) k = t - 61; } else if (t >= 13) k = t - 13;
            if (k >= 0) { float* op = sample ? p.out + O_CONVS + (size_t)((l * 8 + sb) * 3 + k) * 1536 + c0 : p.out + O_CONVP + (size_t)((l * 16 + b) * 3 + k) * 1536 + c0;
                *(f32x4*)op = (f32x4){cur[0], cur[1], cur[2], cur[3]}; *(f32x4*)(op + 4) = (f32x4){cur[4], cur[5], cur[6], cur[7]}; }
#pragma unroll
            for (int e = 0; e < 8; ++e) { r0[e] = r1[e]; r1[e] = r2[e]; r2[e] = cur[e]; }
        }
#pragma unroll
        for (int q = 0; q < 4; ++q) raw[q] = rawn[q];
    }
}
struct GmU { int R0, nrows, h, sb; bool sample; };
__device__ __forceinline__ GmU gm_decode(int gu) { GmU g; g.sample = gu >= 2048; g.sb = 0;
    if (!g.sample) { const int b = gu >> 7, rem = gu & 127; g.h = rem & 7; g.R0 = b * 2048 + 128 * (rem >> 3); g.nrows = 128; } else { const int s = gu - 2048; g.sb = s >> 3; g.h = s & 7; g.R0 = MP + 16 * g.sb; g.nrows = 16; }
    return g; }
__device__ __forceinline__ void gm_load_v(const bf16_t* proj, const GmU& g, int tid, u32x4 (&vr)[4]) {
    const int i = tid >> 2, d0 = (tid & 3) * 32;
#pragma unroll
    for (int c4 = 0; c4 < 4; ++c4) vr[c4] = i < g.nrows ? *(const u32x4*)(proj + (size_t)(g.R0 + i) * PROJW + 1024 + g.h * 128 + d0 + 8 * c4) : (u32x4){0u, 0u, 0u, 0u};
}
__device__ __forceinline__ void gm_load_u(const bf16_t* proj, const GmU& g, int wid, int lane, u32x2 (&uw)[8]) {
    const int fr = lane & 15, fq = lane >> 4, t = 16 * wid + fr;
#pragma unroll
    for (int d = 0; d < 8; ++d) uw[d] = (16 * wid < g.nrows) ? *(const u32x2*)(proj + (size_t)(g.R0 + t) * PROJW + g.h * 128 + 16 * d + 4 * fq) : (u32x2){0u, 0u};
}
__device__ __forceinline__ void gmlp_units(const Params& p, int l, unsigned char* smem, int tid, int wid, int lane) {
    bf16_t* vnT = (bf16_t*)smem;
    const bf16_t* proj = (const bf16_t*)(p.ws + WS_PROJ);
    int gu = blockIdx.x; if (gu >= 2112) return;
    GmU g = gm_decode(gu); u32x4 vr[4]; u32x2 uw[8];
    gm_load_v(proj, g, tid, vr); gm_load_u(proj, g, wid, lane, uw);
    for (;;) {
        const int R0 = g.R0, nrows = g.nrows, h = g.h, sb = g.sb; const bool sample = g.sample;
        {
            const int i = tid >> 2, q = tid & 3, d0 = q * 32;
            if (i < nrows) {
                float v[32];
#pragma unroll
                for (int c4 = 0; c4 < 4; ++c4) { const u32x4 w4 = vr[c4];
                    v[8 * c4 + 0] = gelu_t(bflo(w4.x)); v[8 * c4 + 1] = gelu_t(bfhi(w4.x)); v[8 * c4 + 2] = gelu_t(bflo(w4.y)); v[8 * c4 + 3] = gelu_t(bfhi(w4.y));
                    v[8 * c4 + 4] = gelu_t(bflo(w4.z)); v[8 * c4 + 5] = gelu_t(bfhi(w4.z)); v[8 * c4 + 6] = gelu_t(bflo(w4.w)); v[8 * c4 + 7] = gelu_t(bfhi(w4.w)); }
                float s = 0.f;
#pragma unroll
                for (int e = 0; e < 32; ++e) s += v[e];
                s = quad_sum(s);
                const float mu = s * (1.f / 128.f);
                float q2 = 0.f;
#pragma unroll
                for (int e = 0; e < 32; ++e) { v[e] -= mu; q2 += v[e] * v[e]; }
                q2 = quad_sum(q2);
                const float rs = rsqrtf(q2 * (1.f / 128.f) + 1e-6f);
                const float* ng = p.in[12] + l * 1024 + h * 128 + d0;
#pragma unroll
                for (int e = 0; e < 32; ++e) v[e] = v[e] * rs * ng[e];
#pragma unroll
                for (int e = 0; e < 32; e += 2) { const unsigned w = pk2(v[e], v[e + 1]); vnT[(d0 + e) * 144 + i] = (bf16_t)(w & 0xffffu); vnT[(d0 + e + 1) * 144 + i] = (bf16_t)(w >> 16); }
                if (sample) { float* gv = p.out + O_GMV + (size_t)((l * 8 + sb) * 16 + i) * 1024 + h * 128 + d0;
#pragma unroll
                    for (int e = 0; e < 32; e += 4) *(f32x4*)(gv + e) = (f32x4){v[e], v[e + 1], v[e + 2], v[e + 3]}; }
            } else if (i < 32) {
#pragma unroll
                for (int e = 0; e < 32; ++e) vnT[(d0 + e) * 144 + i] = (bf16_t)0;
            }
        }
        const int gn = gu + gridDim.x; const bool more = gn < 2112;
        if (more) { g = gm_decode(gn); gm_load_v(proj, g, tid, vr); }
        LDS_BARRIER();
        if (16 * wid < nrows) {
            const int fr = lane & 15, fq = lane >> 4, tt = 16 * wid, nk = ((tt + 15) >> 5) + 1;
            f32x4 acc[8];
#pragma unroll
            for (int d = 0; d < 8; ++d) acc[d] = (f32x4){0.f, 0.f, 0.f, 0.f};
            const bf16_t* wm = (const bf16_t*)(p.ws + WS_WM) + (size_t)((l * 8 + h) * 128 + tt + fr) * 128 + 8 * fq;
            for (int kk = 0; kk < nk; ++kk) {
                const bf16x8 bfr = *(const bf16x8*)(wm + 32 * kk);
#pragma unroll
                for (int d = 0; d < 8; ++d) { const bf16x8 afr = *(const bf16x8*)(vnT + (16 * d + fr) * 144 + 32 * kk + 8 * fq); acc[d] = __builtin_amdgcn_mfma_f32_16x16x32_bf16(afr, bfr, acc[d], 0, 0, 0); }
            }
            const int t = tt + fr; const float bias = p.in[14][(l * 8 + h) * 128 + t];
            bf16_t* a2 = (bf16_t*)(p.ws + WS_A2);
#pragma unroll
            for (int d = 0; d < 8; ++d) {
                const int dcol = h * 128 + 16 * d + 4 * fq;
                const float o0 = gelu_t(bflo(uw[d].x)) * (acc[d][0] + bias), o1 = gelu_t(bfhi(uw[d].x)) * (acc[d][1] + bias), o2 = gelu_t(bflo(uw[d].y)) * (acc[d][2] + bias), o3 = gelu_t(bfhi(uw[d].y)) * (acc[d][3] + bias);
                *(u32x2*)(a2 + (size_t)(R0 + t) * 2048 + 1024 + dcol) = (u32x2){pk2(o0, o1), pk2(o2, o3)};
            }
        }
        if (!more) { LDS_BARRIER(); break; }
        gm_load_u(proj, g, wid, lane, uw);
        LDS_BARRIER();
        gu = gn;
    }
}

__device__ __forceinline__ unsigned tr_addr(unsigned base_b, int stride, int k0, int R0, int lane) {
    const int fq = lane >> 4, i = lane & 15; return base_b + (unsigned)(((k0 + 8 * fq + (i >> 2)) * stride + R0 + 4 * (i & 3)) * 2);
}
#define TR_READ2(lo, hi, addr, stride) asm volatile("ds_read_b64_tr_b16 %0, %2\n\tds_read_b64_tr_b16 %1, %2 offset:%3" : "=&v"(lo), "=&v"(hi) : "v"(addr), "n"(4 * (stride) * 2) : "memory")
#define TR_FRAG(lo, hi) ((bf16x8)__builtin_bit_cast(bf16x8, (u32x4){(lo).x, (lo).y, (hi).x, (hi).y}))

__device__ __forceinline__ void ssd_unit(const Params& p, int l, int su, unsigned char* smem, int tid, int wid, int lane, bool ystore) {
    int RB, nch, nL, h; const float* h0 = nullptr; float* hout;
    if (su < 256) { const int b = su >> 4; h = su & 15; RB = b * 2048; nch = 32; nL = 64; hout = p.out + O_SSMP + (size_t)((l * 16 + b) * 16 + h) * 8192; }
    else { const int s = su - 256, sb = s >> 4; h = s & 15; RB = MP + 16 * sb; nch = 1; nL = 16; h0 = p.in[2] + (size_t)((l * 8 + sb) * 16 + h) * 8192; hout = p.out + O_SSMS + (size_t)((l * 8 + sb) * 16 + h) * 8192; }
    const int g = h >> 3, fr = lane & 15, fq = lane >> 4;
    bf16_t* Cs = (bf16_t*)smem; bf16_t* Bs = Cs + 64 * 144; bf16_t* Hb = Bs + 64 * 144; bf16_t* BT = Hb + 64 * 144; bf16_t* XT = BT + 128 * 80; bf16_t* XdT = XT + 64 * 80; bf16_t* Gs = XdT + 64 * 80;
    bf16_t* Zs = Gs + 64 * 80; bf16_t* Xs = Zs + 64 * 80; float* acs = (float*)(Xs + 64 * 80); float* dts = acs + 64; float* ssq2 = dts + 64;
    const bf16_t* proj = (const bf16_t*)(p.ws + WS_PROJ); const bf16_t* bc = (const bf16_t*)(p.ws + WS_BC); bf16_t* a2 = (bf16_t*)(p.ws + WS_A2);
    const unsigned xs_b = (unsigned)((unsigned char*)Xs - smem), bs_b = (unsigned)((unsigned char*)Bs - smem), xd_b = (unsigned)((unsigned char*)XdT - smem);
    const float* dtraw = (const float*)(p.ws + WS_DT); float* ssq = (float*)(p.ws + WS_SSQ);
    const float dtb = p.in[17][l * 16 + h], aneg = -__expf(p.in[18][l * 16 + h]), dsk = p.in[19][l * 16 + h];
    f32x4 st[4];
#pragma unroll
    for (int pt = 0; pt < 4; ++pt) st[pt] = h0 ? *(const f32x4*)(h0 + (size_t)(16 * pt + fr) * 128 + 16 * wid + 4 * fq) : (f32x4){0.f, 0.f, 0.f, 0.f};
    u32x4 px, pz, pb[2], pc[2]; float pdt;
    const int xrow = lane, xseg = wid;
#define SSD_LOAD(R0) do { const u32x4 z4 = {0u, 0u, 0u, 0u}; \
        px = xrow < nL ? *(const u32x4*)(a2 + (size_t)((R0) + xrow) * 2048 + h * 64 + xseg * 8) : z4; \
        pz = xrow < nL ? *(const u32x4*)(proj + (size_t)((R0) + xrow) * PROJW + 2048 + h * 64 + xseg * 8) : z4; \
        _Pragma("unroll") for (int i = 0; i < 2; ++i) { const int row = lane, seg = wid + 8 * i; \
            pb[i] = row < nL ? *(const u32x4*)(bc + (size_t)((R0) + row) * 512 + g * 128 + seg * 8) : z4; \
            pc[i] = row < nL ? *(const u32x4*)(bc + (size_t)((R0) + row) * 512 + 256 + g * 128 + seg * 8) : z4; } \
        pdt = lane < nL ? dtraw[(size_t)((R0) + lane) * 16 + h] : 0.f; } while (0)
    SSD_LOAD(RB);
    for (int c = 0; c < nch; ++c) {
        const int R0 = RB + 64 * c;
        *(u32x4*)(Xs + xrow * 80 + xseg * 8) = px; *(u32x4*)(Zs + xrow * 80 + xseg * 8) = pz;
#pragma unroll
        for (int i = 0; i < 2; ++i) { const int row = lane, seg = wid + 8 * i;
            *(u32x4*)(Bs + row * 144 + seg * 8) = pb[i]; *(u32x4*)(Cs + row * 144 + seg * 8) = pc[i];
        }
#pragma unroll
        for (int pt = 0; pt < 4; ++pt) *(u32x2*)(Hb + (16 * pt + fr) * 144 + 16 * wid + 4 * fq) = (u32x2){pk2(st[pt][0], st[pt][1]), pk2(st[pt][2], st[pt][3])};
        { const float dtv = lane < nL ? softplus_f(pdt + dtb) : 0.f; float ac = dtv * aneg;
#define DPP_ADD(ctrl, rmask) ac += __int_as_float(__builtin_amdgcn_update_dpp(0, __float_as_int(ac), ctrl, rmask, 0xf, true))
          DPP_ADD(0x111, 0xf); DPP_ADD(0x112, 0xf); DPP_ADD(0x114, 0xf); DPP_ADD(0x118, 0xf); DPP_ADD(0x142, 0xa); DPP_ADD(0x143, 0xc);
#undef DPP_ADD
          if (wid == 0) { acs[lane] = ac; dts[lane] = dtv; }
          const float wgt = __expf(__int_as_float(__builtin_amdgcn_readlane(__float_as_int(ac), 63)) - ac) * dtv;
          *(u32x4*)(XdT + xrow * 80 + xseg * 8) = (u32x4){pk2(bflo(px.x) * wgt, bfhi(px.x) * wgt), pk2(bflo(px.y) * wgt, bfhi(px.y) * wgt), pk2(bflo(px.z) * wgt, bfhi(px.z) * wgt), pk2(bflo(px.w) * wgt, bfhi(px.w) * wgt)}; }
        if (c + 1 < nch) SSD_LOAD(R0 + 64);
        LDS_BARRIER();
        const float acL = acs[63];
        { const int lt = wid >> 1;
#pragma unroll
          for (int q = 0; q < 2; ++q) { const int stl = 2 * (wid & 1) + q; const int lrow = 16 * lt + fr, s0 = 16 * stl + 4 * fq;
              u32x2 o = {0u, 0u};
              if (stl <= lt) {
                  f32x4 acc = {0.f, 0.f, 0.f, 0.f};
#pragma unroll
                  for (int kk = 0; kk < 4; ++kk) { const bf16x8 a = *(const bf16x8*)(Bs + (16 * stl + fr) * 144 + 32 * kk + 8 * fq), b = *(const bf16x8*)(Cs + (16 * lt + fr) * 144 + 32 * kk + 8 * fq); acc = __builtin_amdgcn_mfma_f32_16x16x32_bf16(a, b, acc, 0, 0, 0); }
                  const float al = acs[lrow]; const f32x4 as4 = *(const f32x4*)(acs + s0), dt4 = *(const f32x4*)(dts + s0);
                  float gg[4];
#pragma unroll
                  for (int r = 0; r < 4; ++r) gg[r] = (s0 + r <= lrow) ? acc[r] * __expf(al - as4[r]) * dt4[r] : 0.f;
                  o = (u32x2){pk2(gg[0], gg[1]), pk2(gg[2], gg[3])};
              }
              *(u32x2*)(Gs + lrow * 80 + s0) = o; } }
        LDS_BARRIER();
        { const int lt = wid >> 1, lrow = 16 * lt + fr; const float el = __expf(acs[lrow]); float sq = 0.f;
#pragma unroll
          for (int q = 0; q < 2; ++q) { const int pt = 2 * (wid & 1) + q, p0 = 16 * pt + 4 * fq;
              f32x4 ad = {0.f, 0.f, 0.f, 0.f}, ao = {0.f, 0.f, 0.f, 0.f};
              { u32x2 t0, t1, t2, t3; const unsigned ax = tr_addr(xs_b, 80, 0, 16 * pt, lane);
                TR_READ2(t0, t1, ax, 80); TR_READ2(t2, t3, ax + 32 * 80 * 2, 80);
                const bf16x8 b0 = *(const bf16x8*)(Gs + lrow * 80 + 8 * fq), b1 = *(const bf16x8*)(Gs + lrow * 80 + 32 + 8 * fq);
                asm volatile("s_waitcnt lgkmcnt(0)" : "+v"(t0), "+v"(t1), "+v"(t2), "+v"(t3) :: "memory");
                ad = __builtin_amdgcn_mfma_f32_16x16x32_bf16(TR_FRAG(t0, t1), b0, ad, 0, 0, 0); ad = __builtin_amdgcn_mfma_f32_16x16x32_bf16(TR_FRAG(t2, t3), b1, ad, 0, 0, 0); }
#pragma unroll
              for (int kk = 0; kk < 4; ++kk) { const bf16x8 a = *(const bf16x8*)(Hb + (16 * pt + fr) * 144 + 32 * kk + 8 * fq), b = *(const bf16x8*)(Cs + lrow * 144 + 32 * kk + 8 * fq); ao = __builtin_amdgcn_mfma_f32_16x16x32_bf16(a, b, ao, 0, 0, 0); }
              const u32x2 xw = *(const u32x2*)(Xs + lrow * 80 + p0), zw = *(const u32x2*)(Zs + lrow * 80 + p0);
              const float xv[4] = {bflo(xw.x), bfhi(xw.x), bflo(xw.y), bfhi(xw.y)}, zv[4] = {bflo(zw.x), bfhi(zw.x), bflo(zw.y), bfhi(zw.y)};
              float y[4];
#pragma unroll
              for (int r = 0; r < 4; ++r) { y[r] = (ad[r] + el * ao[r] + dsk * xv[r]) * silu_f(zv[r]); sq += y[r] * y[r]; }
              if (lrow < nL && ystore) *(u32x2*)(a2 + (size_t)(R0 + lrow) * 2048 + h * 64 + p0) = (u32x2){pk2(y[0], y[1]), pk2(y[2], y[3])}; }
          ssq2[lrow * 8 + (wid & 1) * 4 + fq] = sq; }
        { const float eL = __expf(acL);
          u32x2 a0, a1, a2, a3, x0[4], x1[4], x2[4], x3[4];
          const unsigned ab = tr_addr(bs_b, 144, 0, 16 * wid, lane), xb0 = tr_addr(xd_b, 80, 0, 0, lane);
          TR_READ2(a0, a1, ab, 144); TR_READ2(a2, a3, ab + 32 * 144 * 2, 144);
#pragma unroll
          for (int pt = 0; pt < 4; ++pt) { TR_READ2(x0[pt], x1[pt], xb0 + 16 * pt * 2, 80); TR_READ2(x2[pt], x3[pt], xb0 + 16 * pt * 2 + 32 * 80 * 2, 80); }
          asm volatile("s_waitcnt lgkmcnt(0)" : "+v"(a0), "+v"(a1), "+v"(a2), "+v"(a3), "+v"(x0[0]), "+v"(x1[0]), "+v"(x2[0]), "+v"(x3[0]), "+v"(x0[1]), "+v"(x1[1]), "+v"(x2[1]), "+v"(x3[1]),
                       "+v"(x0[2]), "+v"(x1[2]), "+v"(x2[2]), "+v"(x3[2]), "+v"(x0[3]), "+v"(x1[3]), "+v"(x2[3]), "+v"(x3[3]) :: "memory");
#pragma unroll
          for (int pt = 0; pt < 4; ++pt) { f32x4 acc = {0.f, 0.f, 0.f, 0.f};
              acc = __builtin_amdgcn_mfma_f32_16x16x32_bf16(TR_FRAG(a0, a1), TR_FRAG(x0[pt], x1[pt]), acc, 0, 0, 0);
              acc = __builtin_amdgcn_mfma_f32_16x16x32_bf16(TR_FRAG(a2, a3), TR_FRAG(x2[pt], x3[pt]), acc, 0, 0, 0);
              st[pt] = eL * st[pt] + acc; } }
        LDS_BARRIER();
        if (tid < nL) { const f32x4 q0 = *(const f32x4*)(ssq2 + tid * 8), q1 = *(const f32x4*)(ssq2 + tid * 8 + 4); ssq[(size_t)(R0 + tid) * 16 + h] = (q0[0] + q0[1]) + (q0[2] + q0[3]) + (q1[0] + q1[1]) + (q1[2] + q1[3]); }
    }
#undef SSD_LOAD
#pragma unroll
    for (int pt = 0; pt < 4; ++pt) *(f32x4*)(hout + (size_t)(16 * pt + fr) * 128 + 16 * wid + 4 * fq) = st[pt];
    LDS_BARRIER();
}

__global__ void __launch_bounds__(512, 2) mk_fwd(Params p) {
    extern __shared__ __attribute__((aligned(16))) unsigned char smem[];
    cg::grid_group grid = cg::this_grid();
    volatile LAS unsigned* xst = (volatile LAS unsigned*)(smem + 131072 + 3072);
    if (threadIdx.x == 0) { xst[0] = 0u; xst[1] = 0u; }
    __syncthreads();
    const XcdBarrier xb = xcd_barrier_post((unsigned*)(p.ws + WS_BAR), xst);
    for (int ph = p.ph_lo; ph < p.ph_hi; ++ph) {
        if (ph > p.ph_lo) {
            if (ph == p.ph_lo + 1) grid.sync(); else xcd_barrier(xb);
#if defined(PROBE_DUP) && (PROBE_DUP & 32)
            xcd_barrier(xb);
#endif
        }
        const int l = ph == 0 ? 0 : (ph - 1) / 11, s = ph == 0 ? 100 : (ph == NPH - 1 ? 101 : (ph - 1) % 11);
        int nrep = 1;
#if defined(PROBE_DUP)
        if ((PROBE_DUP & 1) && s == 100) nrep = 2;
        if ((PROBE_DUP & 2) && (s == 0 || s == 3 || s == 8)) nrep = 2;
        if ((PROBE_DUP & 4) && (s == 1 || s == 9)) nrep = 2;
        if ((PROBE_DUP & 8) && s == 4) nrep = 2;
        if ((PROBE_DUP & 16) && s == 5) nrep = 2;
        if ((PROBE_DUP & 64) && (s == 2 || s == 10)) nrep = 2;
        if ((PROBE_DUP & 128) && s == 7) nrep = 2;
        if ((PROBE_DUP & 256) && s == 6) nrep = 2;
#endif
      for (int rep = 0; rep < nrep; ++rep) {
        if (rep) xcd_barrier(xb);
        int tid_raw = threadIdx.x; asm volatile("" : "+v"(tid_raw));
        const int tid = tid_raw, wid = __builtin_amdgcn_readfirstlane(tid >> 6), lane = tid & 63;
        if (s == 100) {
#ifndef SKIP_P0
            phase0(p, smem, tid, wid, lane);
#endif
            continue; }
        if (s == 101) {
#ifndef SKIP_NORM
            norm_phase<true>(p, 0, 0, false, (const bf16_t*)(p.ws + WS_A2), nullptr, wid, lane);
#endif
            continue; }
        const float* modl = (const float*)(p.ws + WS_MOD) + (size_t)l * 24 * 9216;
        bf16_t* xb = (bf16_t*)((unsigned char*)p.out + 67108864);
        if (s == 0 || s == 3 || s == 8) {
#ifndef SKIP_NORM
 norm_phase<false>(p, l, s == 0 ? 0 : (s == 3 ? 1 : 2), ph == 1, xb, xb, wid, lane);
#endif
 }
        else if (s == 1 || s == 9) { const int j = s == 9;
            pg8::Gemm g{(const bf16_t*)(p.ws + WS_A2), (const bf16_t*)(p.ws + WS_WB1) + (size_t)(l * 2 + j) * 5632 * 1024, MP, 5632, 1024};
            pg8::StaticOrder S; S.init(g.M, g.N, (int)gridDim.x, (int)blockIdx.x);
            EpiSwiglu E{(bf16_t*)(p.ws + WS_PROJ), 0};
#ifndef SKIP_G1
            sg_g1(p, l, j, wid, lane);
            pg8::gemm_phase<EpiSwiglu, pg8::StaticOrder, false>((PG8_LAS unsigned char*)smem, g, S, E, nullptr);
#endif
 }
        else if (s == 2 || s == 10) { const int j = s == 10;
            pg8::Gemm g{(const bf16_t*)(p.ws + WS_PROJ), (const bf16_t*)(p.ws + WS_WB2) + (size_t)(l * 2 + j) * 1024 * DFF, MP, 1024, DFF};
            pg8::StaticOrder S; S.init(g.M, g.N, (int)gridDim.x, (int)blockIdx.x);
            EpiResid<false> E{(l == 3 && j == 1 && rep + 1 == nrep) ? (bf16_t*)(p.ws + WS_A2) : xb, xb, modl + (j ? 8 : 2) * 1024, (rep + 1 < nrep) ? 0.f : 0.5f, nullptr, 0};
#ifndef SKIP_G2
            sg_resid(p, g.A, DFF, g.Bt, E.gate, E.coef, nullptr, wid, lane);
            pg8::gemm_phase<EpiResid<false>, pg8::StaticOrder, false>((PG8_LAS unsigned char*)smem, g, S, E, nullptr);
#endif
 }
        else if (s == 4) {
            pg8::Gemm g{(const bf16_t*)(p.ws + WS_A2), (const bf16_t*)(p.ws + WS_WBIN) + (size_t)l * DINP * 1024, MP, PROJW, 1024};
            pg8::StaticOrder S; S.init(g.M, g.N, (int)gridDim.x, (int)blockIdx.x);
            EpiProj E{(bf16_t*)(p.ws + WS_PROJ), nullptr, 0};
#ifndef SKIP_GIN
            sg_in(p, l, wid, lane);
            pg8::gemm_phase<EpiProj, pg8::StaticOrder, false>((PG8_LAS unsigned char*)smem, g, S, E, nullptr);
#endif
 }
        else if (s == 5) {
#ifndef SKIP_MIXA
#ifndef SKIP_GM
            gmlp_units(p, l, smem, tid, wid, lane);
#endif
#ifndef SKIP_CONV
            for (int u = blockIdx.x; u < 520; u += gridDim.x) conv_unit(p, l, (u + 131) % 520, tid);
#endif
#endif
 }
        else if (s == 6) { for (int u = blockIdx.x; u < 384; u += gridDim.x) {
#ifndef SKIP_SSD
 ssd_unit(p, l, u, smem, tid, wid, lane, rep + 1 == nrep);
#endif
 } }
        else {
            pg8::Gemm g{(const bf16_t*)(p.ws + WS_A2), (const bf16_t*)(p.ws + WS_WBOUT) + (size_t)l * 1024 * 2048, MP, 1024, 2048};
            pg8::StaticOrder S; S.init(g.M, g.N, (int)gridDim.x, (int)blockIdx.x);
            float* rl = (float*)(smem + 131072);
            { const float* ssq = (const float*)(p.ws + WS_SSQ);
              for (int i = 0; i < 2; ++i) { pg8::Unit uu; if (!S.next(i, uu)) break;
                  if (tid < 256) { const f32x4* sp = (const f32x4*)(ssq + (size_t)(uu.pm * 256 + tid) * 16); const f32x4 s4 = sp[0] + sp[1] + sp[2] + sp[3];
                      rl[i * 256 + tid] = rsqrtf((s4[0] + s4[1] + s4[2] + s4[3]) * (1.f / 1024.f) + 1e-6f); } }
              __syncthreads(); }
            EpiResid<true> E{xb, xb, modl + 5 * 1024, (rep + 1 < nrep) ? 0.f : 1.0f, rl, 16};
#ifndef SKIP_GOUT
            sg_resid(p, g.A, 2048, g.Bt, E.gate, E.coef, (const float*)(p.ws + WS_SSQ), wid, lane);
            pg8::gemm_phase<EpiResid<true>, pg8::StaticOrder, false>((PG8_LAS unsigned char*)smem, g, S, E, nullptr);
#endif
 }
      }
    }
}

extern "C" void kernel_launch(void* const* d_in, const int* in_sizes, int n_in, void* d_out, int out_size, void* d_ws, size_t ws_size, hipStream_t stream) {
    static int grid = 0;
    if (grid == 0) {
        if (n_in != 25 || ws_size < WS_END) { fprintf(stderr, "kernel_launch: unexpected n_in %d or workspace %zu < %zu\n", n_in, ws_size, (size_t)WS_END); grid = -1; return; }
        int dev = 0, cus = 0, per_cu = 0;
        hipGetDevice(&dev); hipDeviceGetAttribute(&cus, hipDeviceAttributeMultiprocessorCount, dev);
        if (hipFuncSetAttribute((const void*)mk_fwd, hipFuncAttributeMaxDynamicSharedMemorySize, LDS_BYTES) != hipSuccess) { fprintf(stderr, "kernel_launch: hipFuncSetAttribute failed\n"); grid = -1; return; }
        if (hipOccupancyMaxActiveBlocksPerMultiprocessor(&per_cu, (const void*)mk_fwd, 512, LDS_BYTES) != hipSuccess || per_cu < 1) { fprintf(stderr, "kernel_launch: occupancy query gave %d\n", per_cu); per_cu = 1; (void)hipGetLastError(); }
        grid = cus * (per_cu > 1 ? 1 : per_cu);
    }
    if (grid < 0) return;
    Params p{};
    for (int i = 0; i < 25; ++i) p.in[i] = (const float*)d_in[i];
    p.out = (float*)d_out; p.ws = (unsigned char*)d_ws;
#if MK_MULTI
    for (int ph = 0; ph < NPH; ++ph) { p.ph_lo = ph; p.ph_hi = ph + 1; hipLaunchKernelGGL(mk_fwd, dim3(grid), dim3(512), LDS_BYTES, stream, p); }
#else
    p.ph_lo = 0; p.ph_hi = NPH;
    if (hipMemsetAsync((unsigned char*)d_ws + WS_BAR, 0, 16384, stream) != hipSuccess) { fprintf(stderr, "kernel_launch: memset of the barrier words failed\n"); return; }
    void* args[] = {&p};
    const hipError_t e = hipLaunchCooperativeKernel((const void*)mk_fwd, dim3(grid), dim3(512), args, LDS_BYTES, stream);
    if (e != hipSuccess) fprintf(stderr, "kernel_launch: cooperative launch failed: %s (grid %d)\n", hipGetErrorString(e), grid);
#endif
}
```

```cpp
#include <hip/hip_runtime.h>
#include <hip/hip_cooperative_groups.h>
#include <cstdio>
namespace cg = cooperative_groups;

#ifndef MK_MULTI
#define MK_MULTI 0
#endif

typedef unsigned short bf16_t;
typedef short bf16x8 __attribute__((ext_vector_type(8)));
typedef float f32x4 __attribute__((ext_vector_type(4)));
typedef float f32x16 __attribute__((ext_vector_type(16)));
typedef unsigned u32x4 __attribute__((ext_vector_type(4)));
typedef unsigned u32x2 __attribute__((ext_vector_type(2)));

constexpr int DM = 1024, MP = 32768  , MV = 32896  , MPAD = 33024  ;
constexpr int DFF = 2816, DIN = 4624, DINP = 4864, PROJW = 4608, NPH = 46;
constexpr int LDS_BYTES = 131072 + 3072 + 16;
constexpr size_t O_YS = 33554432, O_SSMP = 33685504, O_CONVP = 42074112, O_SSMS = 42369024, O_CONVS = 46563328, O_GMV = 46710784;
constexpr size_t WS_WB1 = 0;
constexpr size_t WS_WB2 = WS_WB1 + (size_t)8 * 5632 * 1024 * 2;
constexpr size_t WS_WBIN = WS_WB2 + (size_t)8 * 1024 * 2816 * 2;
constexpr size_t WS_WBOUT = WS_WBIN + (size_t)4 * DINP * 1024 * 2;
constexpr size_t WS_WM = WS_WBOUT + (size_t)4 * 1024 * 2048 * 2;
constexpr size_t WS_MOD = WS_WM + (size_t)4 * 8 * 128 * 128 * 2;
constexpr size_t WS_MODF = WS_MOD + (size_t)4 * 24 * 9216 * 4;
constexpr size_t WS_PROJ = WS_MODF + (size_t)24 * 2048 * 4;
constexpr size_t WS_DT = WS_PROJ + (size_t)MPAD * PROJW * 2;
constexpr size_t WS_BC = WS_DT + (size_t)MPAD * 16 * 4;
constexpr size_t WS_A2 = WS_BC + (size_t)MPAD * 512 * 2;
constexpr size_t WS_SSQ = WS_A2 + (size_t)MPAD * 2048 * 2;
constexpr size_t WS_BAR = WS_SSQ + (size_t)MPAD * 16 * 4;
constexpr size_t WS_END = WS_BAR + 16384;

struct Params { const float* in[25]; float* out; unsigned char* ws; int ph_lo, ph_hi; };

__device__ __forceinline__ float silu_f(float x) { return x * __builtin_amdgcn_rcpf(1.f + __builtin_amdgcn_exp2f(-1.4426950408889634f * x)); }
__device__ __forceinline__ float gelu_t(float x) { const float t = x * x; const float u = x * (-2.3022082f - 0.1029432f * t); return x * __builtin_amdgcn_rcpf(1.f + __builtin_amdgcn_exp2f(u)); }
__device__ __forceinline__ float softplus_f(float x) { return fmaxf(x, 0.f) + __logf(1.f + __expf(-fabsf(x))); }
__device__ __forceinline__ float bflo(unsigned w) { return __uint_as_float(w << 16); }
__device__ __forceinline__ float bfhi(unsigned w) { return __uint_as_float(w & 0xffff0000u); }
__device__ __forceinline__ unsigned pk2(float lo, float hi) { unsigned r; asm volatile("v_cvt_pk_bf16_f32 %0, %1, %2" : "=v"(r) : "v"(lo), "v"(hi)); return r; }
__device__ __forceinline__ int modrow(int row) { int r = row < MP ? (row >> 11) : 16 + ((row - MP) >> 4); return r > 23 ? 23 : r; }

__device__ __forceinline__ float wave_sum(float v) {
#define DPP_ADDV(ctrl, rmask) v += __int_as_float(__builtin_amdgcn_update_dpp(0, __float_as_int(v), ctrl, rmask, 0xf, true))
    DPP_ADDV(0x111, 0xf); DPP_ADDV(0x112, 0xf); DPP_ADDV(0x114, 0xf); DPP_ADDV(0x118, 0xf); DPP_ADDV(0x142, 0xa); DPP_ADDV(0x143, 0xc);
#undef DPP_ADDV
    return __int_as_float(__builtin_amdgcn_readlane(__float_as_int(v), 63));
}
__device__ __forceinline__ float quad_sum(float v) {
    v += __int_as_float(__builtin_amdgcn_update_dpp(0, __float_as_int(v), 0xB1, 0xf, 0xf, true));
    v += __int_as_float(__builtin_amdgcn_update_dpp(0, __float_as_int(v), 0x4E, 0xf, 0xf, true));
    return v;
}
namespace pg8 {
#define PG8_LAS __attribute__((address_space(3)))
typedef unsigned short bf16_t;
typedef short bf16x8 __attribute__((ext_vector_type(8)));
typedef float f32x4 __attribute__((ext_vector_type(4)));
typedef unsigned u32x4 __attribute__((ext_vector_type(4)));
constexpr int BM = 256, BK = 64, HALF = 128, HTB = HALF * BK * 2  , STAGE_BYTES = 8 * HTB, NXCD = 8, WGM = 8;

__host__ __device__ __forceinline__ int lds_byte(int r, int c) { const int st = (r >> 4) * 2 + (c >> 5), rr = r & 15, cc = c & 31, ob = rr * 64 + cc * 2; return st * 1024 + (ob ^ (((ob >> 9) & 1) << 5)); }
__host__ __device__ __forceinline__ void stage_rc(int b, int& R, int& C) { const int st = b / 1024, sb = b % 1024, swz = sb ^ (((sb >> 9) & 1) << 5); R = (st >> 1) * 16 + swz / 64; C = (st & 1) * 32 + (swz % 64) / 2; }
__host__ __device__ __forceinline__ int perm32(int rho) { const int n = rho >> 4, i = rho & 15; return 8 * (i >> 2) + 4 * n + (i & 3); }
struct Unit { int pm, pn; };
struct Gemm { const bf16_t* A; const bf16_t* Bt; int M, N, K; };
struct StaticOrder {
    int nM, nN, nwg, G, c;
    __host__ __device__ void init(int M, int N, int G_, int c_) { nM = M / BM; nN = N / BM; nwg = nM * nN; G = G_; c = c_; }
    __host__ __device__ bool next(int i, Unit& u) const {
        const long L = (long)i * G + c; if (L >= nwg) return false;
        int wgid = (int)L; { const int q = nwg / NXCD, r = nwg % NXCD, xcd = wgid % NXCD, off = wgid / NXCD; wgid = (xcd < r ? xcd * (q + 1) : r * (q + 1) + (xcd - r) * q) + off; }
        const int nig = WGM * nN, gid = wgid / nig, fm = gid * WGM, gsz = (nM - fm) < WGM ? (nM - fm) : WGM;
        u.pm = fm + ((wgid % nig) % gsz); u.pn = (wgid % nig) / gsz; return true;
    }
    __device__ __forceinline__ void a_ready(const Unit&) const {}
    __device__ __forceinline__ void done(const Unit&) const {}
};
__device__ __forceinline__ unsigned cvt_pk_bf16(float lo, float hi) { unsigned r; asm volatile("v_cvt_pk_bf16_f32 %0, %1, %2" : "=v"(r) : "v"(lo), "v"(hi)); return r; }
typedef float f32x2 __attribute__((ext_vector_type(2)));
template <class Epi, class Sched, bool STAMP = false>
__device__ __forceinline__ void gemm_phase(PG8_LAS unsigned char* lds, const Gemm g, const Sched& S, const Epi& E, unsigned long long* stamps) {
    int tid_raw = threadIdx.x; asm volatile("" : "+v"(tid_raw));
    const int tid = tid_raw, wid = __builtin_amdgcn_readfirstlane(tid >> 6), lane = tid & 63, wr = wid >> 2, wc = wid & 3, fr = lane & 15, fq = lane >> 4;
    const int K = g.K, nt = K / BK;
    int ts_lo = 0, ts_hi = 0, nts = 0; const unsigned long long rt_entry = STAMP ? (unsigned long long)wall_clock64() : 0ull;
#define PG8_STAMP() do { if (STAMP && wid == 0 && nts < 64) { const unsigned long long _c = (unsigned long long)clock64(); \
        ts_lo = (lane == nts) ? (int)(unsigned)_c : ts_lo; ts_hi = (lane == nts) ? (int)(unsigned)(_c >> 32) : ts_hi; ++nts; } } while (0)
    PG8_STAMP();
    unsigned voffA[2], voffB[2];
#pragma unroll
    for (int i = 0; i < 2; ++i) { int R, C; stage_rc(tid * 16 + i * 8192, R, C); const int Rb = Epi::PERM ? ((R & ~31) + perm32(R & 31)) : R;
        voffA[i] = (unsigned)(R * K + C) * 2u; voffB[i] = (unsigned)(Rb * K + C) * 2u; }
    const size_t kstep = (size_t)(BK * 2);
    const size_t hstep = (size_t)HALF * K * 2;
    const size_t tstep = 2 * hstep;
    const unsigned ldsw = (unsigned)wid * 1024u;
    const int aoff = lds_byte(wr * 64 + fr, fq * 8), boff = lds_byte(wc * 32 + fr, fq * 8);
#define PG8_SA(b, h) (((b) * 2 + (h)) * HTB)
#define PG8_SB(b, h) ((4 + (b) * 2 + (h)) * HTB)
#define PG8_STAGE(bufoff, gbase, voff) do { _Pragma("unroll") for (int _i = 0; _i < 2; ++_i) \
        __builtin_amdgcn_global_load_lds((const unsigned*)((const char*)(gbase) + (voff)[_i]), (PG8_LAS unsigned*)(lds + (bufoff) + ldsw + _i * 8192), 16, 0, 0); } while (0)
#define PG8_LDA(dst, b, h) do { _Pragma("unroll") for (int m = 0; m < 4; ++m) _Pragma("unroll") for (int k = 0; k < 2; ++k) dst[m][k] = *(const PG8_LAS bf16x8*)(lds + PG8_SA(b, h) + aoff + m * 2048 + k * 1024); } while (0)
#define PG8_LDB(dst, b, h) do { _Pragma("unroll") for (int n = 0; n < 2; ++n) _Pragma("unroll") for (int k = 0; k < 2; ++k) dst[n][k] = *(const PG8_LAS bf16x8*)(lds + PG8_SB(b, h) + boff + n * 2048 + k * 1024); } while (0)
#define PG8_MMA(ai, bj, At, Bt) do { __builtin_amdgcn_s_setprio(1); _Pragma("unroll") for (int m = 0; m < 4; ++m) _Pragma("unroll") for (int n = 0; n < 2; ++n) _Pragma("unroll") for (int k = 0; k < 2; ++k) \
        acc[ai][bj][m][n] = __builtin_amdgcn_mfma_f32_16x16x32_bf16(Bt[n][k], At[m][k], acc[ai][bj][m][n], 0, 0, 0); __builtin_amdgcn_s_setprio(0); } while (0)
#define PG8_WAIT_V(n) asm volatile("s_waitcnt vmcnt(" #n ")" ::: "memory")
#define PG8_WAIT_L(n) asm volatile("s_waitcnt lgkmcnt(" #n ")" ::: "memory")
#define PG8_BAR __builtin_amdgcn_s_barrier()
#define PG8_SCHED __builtin_amdgcn_sched_barrier(0)
    Unit cur, nxt; int ui = 0;
    if (!S.next(0, cur)) return;
    f32x4 acc[2][2][4][2];
#pragma unroll
    for (int a = 0; a < 2; ++a)
#pragma unroll
        for (int b = 0; b < 2; ++b)
#pragma unroll
            for (int m = 0; m < 4; ++m)
#pragma unroll
                for (int n = 0; n < 2; ++n) acc[a][b][m][n] = (f32x4){0.f, 0.f, 0.f, 0.f};
    bf16x8 At[4][2], B0[2][2], B1[2][2];
    const char* cA = (const char*)g.A + (size_t)cur.pm * tstep; const char* cB = (const char*)g.Bt + (size_t)cur.pn * tstep;
    S.a_ready(cur);
    PG8_STAGE(PG8_SB(0, 0), cB, voffB); PG8_STAGE(PG8_SA(0, 0), cA, voffA); PG8_STAGE(PG8_SB(0, 1), cB + hstep, voffB); PG8_STAGE(PG8_SA(0, 1), cA + hstep, voffA);
    if (wr == 1) PG8_BAR;
    PG8_WAIT_V(4); PG8_BAR;
    PG8_STAGE(PG8_SB(1, 0), cB + kstep, voffB); PG8_STAGE(PG8_SA(1, 0), cA + kstep, voffA); PG8_STAGE(PG8_SB(1, 1), cB + hstep + kstep, voffB);
    PG8_WAIT_V(6); PG8_BAR;
    PG8_STAMP();
    for (;;) {
        const bool has_next = S.next(ui + 1, nxt);
        const char* nA = has_next ? (const char*)g.A + (size_t)nxt.pm * tstep : cA; const char* nB = has_next ? (const char*)g.Bt + (size_t)nxt.pn * tstep : cB;
        for (int t = 0; t < nt; t += 2) {
            if constexpr (Epi::MIDK) { if (t == E.midk_t) E.mid(acc, ui, wr, wc, fr, fq); }
            const bool last = (t == nt - 2);
            const char* a1 = cA + (size_t)(t + 1) * kstep;
            const char* a2 = last ? nA : cA + (size_t)(t + 2) * kstep; const char* b2 = last ? nB : cB + (size_t)(t + 2) * kstep;
            const char* a3 = a2 + kstep; const char* b3 = b2 + kstep;
            if (last && has_next) S.a_ready(nxt);
            PG8_LDB(B0, 0, 0); PG8_SCHED; PG8_LDA(At, 0, 0); PG8_STAGE(PG8_SA(1, 1), a1 + hstep, voffA);
            PG8_WAIT_L(8); PG8_BAR; PG8_WAIT_L(0); PG8_MMA(0, 0, At, B0); PG8_BAR; PG8_SCHED;
            PG8_LDB(B1, 0, 1); PG8_STAGE(PG8_SB(0, 0), b2, voffB);
            PG8_BAR; PG8_WAIT_L(0); PG8_MMA(0, 1, At, B1); PG8_BAR;
            PG8_LDA(At, 0, 1); PG8_STAGE(PG8_SA(0, 0), a2, voffA);
            PG8_BAR; PG8_WAIT_L(0); PG8_MMA(1, 0, At, B0); PG8_BAR; PG8_SCHED;
            PG8_STAGE(PG8_SB(0, 1), b2 + hstep, voffB);
            PG8_WAIT_V(6); PG8_BAR; PG8_MMA(1, 1, At, B1); PG8_BAR;
            PG8_LDB(B0, 1, 0); PG8_SCHED; PG8_LDA(At, 1, 0); PG8_STAGE(PG8_SA(0, 1), a2 + hstep, voffA);
            PG8_WAIT_L(8); PG8_BAR; PG8_WAIT_L(0); PG8_MMA(0, 0, At, B0); PG8_BAR; PG8_SCHED;
            PG8_LDB(B1, 1, 1); PG8_STAGE(PG8_SB(1, 0), b3, voffB);
            PG8_BAR; PG8_WAIT_L(0); PG8_MMA(0, 1, At, B1); PG8_BAR;
            PG8_LDA(At, 1, 1); PG8_STAGE(PG8_SA(1, 0), a3, voffA);
            PG8_BAR; PG8_WAIT_L(0); PG8_MMA(1, 0, At, B0); PG8_BAR; PG8_SCHED;
            PG8_STAGE(PG8_SB(1, 1), b3 + hstep, voffB);
            PG8_WAIT_V(6); PG8_BAR; PG8_MMA(1, 1, At, B1); PG8_BAR;
        }
        PG8_STAMP();
        if constexpr (!Epi::AFTER_DRAIN) { E(acc, cur, wr, wc, fr, fq); S.done(cur); }
        PG8_STAMP();
        if (!has_next) break;
#pragma unroll
        for (int a = 0; a < 2; ++a)
#pragma unroll
            for (int b = 0; b < 2; ++b)
#pragma unroll
                for (int m = 0; m < 4; ++m)
#pragma unroll
                    for (int n = 0; n < 2; ++n) acc[a][b][m][n] = (f32x4){0.f, 0.f, 0.f, 0.f};
        cur = nxt; cA = nA; cB = nB; ++ui;
    }
    PG8_WAIT_V(0);
    if (wr == 0) PG8_BAR;
    PG8_BAR;
    if constexpr (Epi::AFTER_DRAIN) { E.fused(acc, cur, wr, wc, fr, fq, lds, wid, lane); S.done(cur); }
    PG8_STAMP();
    if (STAMP && wid == 0) { stamps[lane] = lane < nts ? (((unsigned long long)(unsigned)ts_hi << 32) | (unsigned)ts_lo) : 0ull;
        if (lane == 62) stamps[62] = rt_entry; if (lane == 63) stamps[63] = (unsigned long long)wall_clock64(); }
#undef PG8_STAMP
#undef PG8_SA
#undef PG8_SB
#undef PG8_STAGE
#undef PG8_LDA
#undef PG8_LDB
#undef PG8_MMA
#undef PG8_WAIT_V
#undef PG8_WAIT_L
#undef PG8_BAR
#undef PG8_SCHED
}
}
#define XB_TMO      128
#define XB_XCNT(j)  (256  + 64 * (j))
#define XB_XSUB(j)  (1280 + 64 * (j))
#define XB_XGEN(j)  (2304 + 64 * (j))
#define XB_TOP      3328
#define XB_TOPGEN   3392
#define XCD_BAR_WORDS 3456
#define XB_SPIN_CAP (1u << 18)
#define LAS __attribute__((address_space(3)))

__device__ __forceinline__ unsigned xb_ld(unsigned* p)              { return __hip_atomic_load(p, __ATOMIC_RELAXED, __HIP_MEMORY_SCOPE_AGENT); }
__device__ __forceinline__ unsigned xb_add(unsigned* p, unsigned v) { return __hip_atomic_fetch_add(p, v, __ATOMIC_RELAXED, __HIP_MEMORY_SCOPE_AGENT); }
__device__ __forceinline__ unsigned xb_xcc_id() { return (unsigned)__builtin_amdgcn_s_getreg((3 << 11) | 20) & 0xFu; }
#define XB_SPIN(cond, bar) do { unsigned _sp = 0; while (cond) { __builtin_amdgcn_s_sleep(1); \
    if ((++_sp & 255u) == 0u) { if (xb_ld(&(bar)[XB_TMO])) break; if (_sp > XB_SPIN_CAP) { atomicAdd(&(bar)[XB_TMO], 1u); break; } } } } while (0)

struct XcdBarrier {
    unsigned* bar; unsigned x;
    volatile LAS unsigned* st;
};

__device__ __forceinline__ XcdBarrier xcd_barrier_post(unsigned* bar, volatile LAS unsigned* st) {
    XcdBarrier b; b.bar = bar; b.x = xb_xcc_id(); b.st = st;
    if (threadIdx.x == 0) (void)xb_add(&bar[XB_XCNT(b.x)], 1u);
    return b;
}
__device__ __forceinline__ void xcd_barrier_complete(unsigned* bar, unsigned x, unsigned& nloc, unsigned& nx) {
    const unsigned G = gridDim.x * gridDim.y * gridDim.z;
    unsigned sum, cnt, mine, sp = 0u;
    for (;;) {
        sum = 0u; cnt = 0u; mine = 0u;
#pragma unroll
        for (unsigned j = 0; j < 16; ++j) { const unsigned c = xb_ld(&bar[XB_XCNT(j)]); sum += c; cnt += (c > 0u) ? 1u : 0u; mine = (j == x) ? c : mine; }
        if (sum == G) break;
        __builtin_amdgcn_s_sleep(1);
        if ((++sp & 255u) == 0u) { if (xb_ld(&bar[XB_TMO])) break; if (sp > XB_SPIN_CAP) { atomicAdd(&bar[XB_TMO], 1u); break; } }
    }
    nloc = mine > 0u ? mine : 1u; nx = cnt > 0u ? cnt : 1u;
}

__device__ __forceinline__ void xcd_barrier(const XcdBarrier& b) {
    asm volatile("s_waitcnt vmcnt(0)" ::: "memory");
    __syncthreads();
    if (threadIdx.x == 0) {
        unsigned* bar = b.bar;
        __builtin_amdgcn_s_waitcnt(0);
        unsigned nloc = b.st[0], nx = b.st[1];
        if (nloc == 0u) { xcd_barrier_complete(bar, b.x, nloc, nx); b.st[0] = nloc; b.st[1] = nx; }
        const unsigned old = xb_add(&bar[XB_XSUB(b.x)], 1u);
        const unsigned gen = old / nloc;
        if (old + 1u == (gen + 1u) * nloc) {
            __builtin_amdgcn_fence(__ATOMIC_RELEASE, "agent");
            asm volatile("s_waitcnt vmcnt(0)" ::: "memory");
            const unsigned og = xb_add(&bar[XB_TOP], 1u);
            const unsigned tg = og / nx;
            if (og + 1u == (tg + 1u) * nx) xb_add(&bar[XB_TOPGEN], 1u);
            else XB_SPIN(xb_ld(&bar[XB_TOPGEN]) == tg, bar);
            __builtin_amdgcn_fence(__ATOMIC_ACQUIRE, "agent");
            xb_add(&bar[XB_XGEN(b.x)], 1u);
            asm volatile("s_waitcnt vmcnt(0)" ::: "memory");
        } else {
            XB_SPIN(xb_ld(&bar[XB_XGEN(b.x)]) == gen, bar);
            __builtin_amdgcn_fence(__ATOMIC_ACQUIRE, "agent");
            asm volatile("s_waitcnt vmcnt(0)" ::: "memory");
        }
    }
    __syncthreads();
}
#define LDS_BARRIER() do { asm volatile("s_waitcnt lgkmcnt(0)" ::: "memory"); __builtin_amdgcn_s_barrier(); asm volatile("" ::: "memory"); } while (0)

struct EpiSwiglu {
    static constexpr bool PERM = true, AFTER_DRAIN = false, MIDK = false;
    bf16_t* H; int midk_t;
    __device__ __forceinline__ void operator()(const f32x4 (&acc)[2][2][4][2], const pg8::Unit& u, int wr, int wc, int fr, int fq) const {
        const int row0 = u.pm * 256 + wr * 64 + fr, col0 = u.pn * 128 + wc * 32 + 8 * fq;
#pragma unroll
        for (int ai = 0; ai < 2; ++ai)
#pragma unroll
            for (int m = 0; m < 4; ++m) {
                bf16_t* rowp = H + (size_t)(row0 + ai * 128 + m * 16) * DFF + col0;
                const f32x4 g0 = acc[ai][0][m][0], g1 = acc[ai][0][m][1], u0 = acc[ai][1][m][0], u1 = acc[ai][1][m][1];
                u32x4 w;
                w.x = pk2(silu_f(g0[0]) * u0[0], silu_f(g0[1]) * u0[1]); w.y = pk2(silu_f(g0[2]) * u0[2], silu_f(g0[3]) * u0[3]);
                w.z = pk2(silu_f(g1[0]) * u1[0], silu_f(g1[1]) * u1[1]); w.w = pk2(silu_f(g1[2]) * u1[2], silu_f(g1[3]) * u1[3]);
                *(u32x4*)rowp = w;
            }
    }
};
template <bool MID> struct EpiResid {
    static constexpr bool PERM = true, AFTER_DRAIN = false, MIDK = MID;
    bf16_t* X; const bf16_t* Xin; const float* gate; float coef; const float* rinv; int midk_t;
    __device__ __forceinline__ void operator()(const f32x4 (&acc)[2][2][4][2], const pg8::Unit& u, int wr, int wc, int fr, int fq) const {
        const int col0 = u.pn * 256 + wc * 32 + 8 * fq;
        const float* gp = gate + (size_t)(u.pm >> 3) * 9216 + col0;
        f32x4 gv[2][2];
#pragma unroll
        for (int bj = 0; bj < 2; ++bj)
#pragma unroll
            for (int n = 0; n < 2; ++n) gv[bj][n] = coef * *(const f32x4*)(gp + bj * 128 + 4 * n);
#pragma unroll
        for (int ai = 0; ai < 2; ++ai) {
            u32x4 xw[4][2];
#pragma unroll
            for (int m = 0; m < 4; ++m)
#pragma unroll
                for (int bj = 0; bj < 2; ++bj) xw[m][bj] = *(const u32x4*)(Xin + (size_t)(u.pm * 256 + ai * 128 + wr * 64 + m * 16 + fr) * DM + col0 + bj * 128);
#pragma unroll
            for (int m = 0; m < 4; ++m)
#pragma unroll
                for (int bj = 0; bj < 2; ++bj) { const u32x4 w = xw[m][bj]; const f32x4 a0 = gv[bj][0] * acc[ai][bj][m][0], a1 = gv[bj][1] * acc[ai][bj][m][1];
                    const u32x4 o = {pk2(bflo(w.x) + a0[0], bfhi(w.x) + a0[1]), pk2(bflo(w.y) + a0[2], bfhi(w.y) + a0[3]), pk2(bflo(w.z) + a1[0], bfhi(w.z) + a1[1]), pk2(bflo(w.w) + a1[2], bfhi(w.w) + a1[3])};
                    *(u32x4*)(X + (size_t)(u.pm * 256 + ai * 128 + wr * 64 + m * 16 + fr) * DM + col0 + bj * 128) = o; }
            asm volatile("" ::: "memory");
        }
    }
    __device__ __forceinline__ void mid(f32x4 (&acc)[2][2][4][2], int ui, int wr, int wc, int fr, int fq) const {
        const float* rl = rinv + ui * 256 + wr * 64 + fr;
#pragma unroll
        for (int ai = 0; ai < 2; ++ai)
#pragma unroll
            for (int m = 0; m < 4; ++m) {
                const float r = rl[ai * 128 + m * 16];
#pragma unroll
                for (int bj = 0; bj < 2; ++bj)
#pragma unroll
                    for (int n = 0; n < 2; ++n) acc[ai][bj][m][n] *= r;
            }
    }
};
struct EpiProj {
    static constexpr bool PERM = true, AFTER_DRAIN = false, MIDK = false;
    bf16_t* P; float* DT; int midk_t;
    __device__ __forceinline__ void operator()(const f32x4 (&acc)[2][2][4][2], const pg8::Unit& u, int wr, int wc, int fr, int fq) const {
        const int row0 = u.pm * 256 + wr * 64 + fr;
        {
            const int col0 = u.pn * 256 + wc * 32 + 8 * fq;
#pragma unroll
            for (int ai = 0; ai < 2; ++ai)
#pragma unroll
                for (int m = 0; m < 4; ++m) {
                    bf16_t* rowp = P + (size_t)(row0 + ai * 128 + m * 16) * PROJW + col0;
#pragma unroll
                    for (int bj = 0; bj < 2; ++bj) { const f32x4 v0 = acc[ai][bj][m][0], v1 = acc[ai][bj][m][1]; u32x4 w; w.x = pk2(v0[0], v0[1]); w.y = pk2(v0[2], v0[3]); w.z = pk2(v1[0], v1[1]); w.w = pk2(v1[2], v1[3]); *(u32x4*)(rowp + bj * 128) = w; }
                }
        }
    }
};


__device__ __forceinline__ f32x4 sg_dot(const bf16_t* A, int lda, int row0, const bf16_t* Bt, int ldb, int n0, int k0, int nk, int wid, int lane) {
    const int fr = lane & 15, fq = lane >> 4;
    const bf16_t* ap = A + (size_t)(row0 + 16 * wid + fr) * lda + k0 + 8 * fq; const bf16_t* bp = Bt + (size_t)(n0 + fr) * ldb + k0 + 8 * fq;
    f32x4 acc = {0.f, 0.f, 0.f, 0.f};
    for (int kb = 0; kb < nk; kb += 16) {
        bf16x8 a[16], bb[16];
#pragma unroll
        for (int j = 0; j < 16; ++j) if (kb + j < nk) { a[j] = *(const bf16x8*)(ap + 32 * (kb + j)); bb[j] = *(const bf16x8*)(bp + 32 * (kb + j)); }
#pragma unroll
        for (int j = 0; j < 16; ++j) if (kb + j < nk) acc = __builtin_amdgcn_mfma_f32_16x16x32_bf16(bb[j], a[j], acc, 0, 0, 0);
    }
    return acc;
}
__device__ __forceinline__ void sg_g1(const Params& p, int l, int j, int wid, int lane) {
    const bf16_t* A = (const bf16_t*)(p.ws + WS_A2); const bf16_t* Bt = (const bf16_t*)(p.ws + WS_WB1) + (size_t)(l * 2 + j) * 5632 * 1024; bf16_t* H = (bf16_t*)(p.ws + WS_PROJ);
    const int fr = lane & 15, fq = lane >> 4;
    for (int it = blockIdx.x; it < 176; it += gridDim.x) {
        const int c0 = 16 * it, rg = 256 * (c0 >> 7) + (c0 & 127);
        const f32x4 g = sg_dot(A, 1024, MP, Bt, 1024, rg, 0, 32, wid, lane), u = sg_dot(A, 1024, MP, Bt, 1024, rg + 128, 0, 32, wid, lane);
        *(u32x2*)(H + (size_t)(MP + 16 * wid + fr) * DFF + c0 + 4 * fq) = (u32x2){pk2(silu_f(g[0]) * u[0], silu_f(g[1]) * u[1]), pk2(silu_f(g[2]) * u[2], silu_f(g[3]) * u[3])};
    }
}
__device__ __forceinline__ void sg_resid(const Params& p, const bf16_t* A, int K, const bf16_t* Bt, const float* gate, float coef, const float* ssq, int wid, int lane) {
    const int fr = lane & 15, fq = lane >> 4, row = MP + 16 * wid + fr; const int kq = K >> 2;
    for (int it = blockIdx.x; it < 256; it += gridDim.x) {
        const int ct = it >> 2, ks = it & 3;
        f32x4 acc = sg_dot(A, K, MP, Bt, K, 16 * ct, ks * kq, kq >> 5, wid, lane);
        if (ssq && ks < 2) { const f32x4* sp = (const f32x4*)(ssq + (size_t)row * 16); const f32x4 s4 = sp[0] + sp[1] + sp[2] + sp[3]; acc *= rsqrtf((s4[0] + s4[1] + s4[2] + s4[3]) * (1.f / 1024.f) + 1e-6f); }
        const f32x4 gv = *(const f32x4*)(gate + (size_t)modrow(row) * 9216 + 16 * ct + 4 * fq);
        float* xp = p.out + (size_t)row * DM + 16 * ct + 4 * fq;
#pragma unroll
        for (int r = 0; r < 4; ++r) atomicAdd(xp + r, coef * gv[r] * acc[r]);
    }
}
__device__ __forceinline__ void sg_in(const Params& p, int l, int wid, int lane) {
    const bf16_t* A = (const bf16_t*)(p.ws + WS_A2); const bf16_t* Bt = (const bf16_t*)(p.ws + WS_WBIN) + (size_t)l * DINP * 1024; bf16_t* P = (bf16_t*)(p.ws + WS_PROJ); float* DT = (float*)(p.ws + WS_DT);
    const int fr = lane & 15, fq = lane >> 4;
    for (int it = blockIdx.x; it < 289 + 256; it += gridDim.x) {
        const int ct = it < 289 ? it : 288, row0 = it < 289 ? MP : 128 * (it - 289);
        const f32x4 acc = sg_dot(A, 1024, row0, Bt, 1024, 16 * ct, 0, 32, wid, lane);
        const int row = row0 + 16 * wid + fr;
        if (ct < 288) *(u32x2*)(P + (size_t)row * PROJW + 16 * ct + 4 * fq) = (u32x2){pk2(acc[0], acc[1]), pk2(acc[2], acc[3])};
        else *(f32x4*)(DT + (size_t)row * 16 + 4 * fq) = acc;
    }
}

__device__ __forceinline__ void p0_gemv(const Params& p, int u, unsigned char* smem, int wid, int lane) {
    const float* src; const float* bias; float* dst; int ld, n0;
    if (u < 576) { const int l = u / 144; n0 = (u % 144) * 64; src = p.in[6] + (size_t)l * 1024 * 9216; bias = p.in[7] + l * 9216; dst = (float*)(p.ws + WS_MOD) + (size_t)l * 24 * 9216; ld = 9216; }
    else { n0 = (u - 576) * 64; src = p.in[23]; bias = p.in[24]; dst = (float*)(p.ws + WS_MODF); ld = 2048; }
    const int i = lane & 31, kh = lane >> 5, cgp = wid & 1, kq = wid >> 1; const bool valid = i < 24;
    const float* cptr = (i < 16 ? p.in[4] + i * 1024 : p.in[5] + ((valid ? i : 16) - 16) * 1024) + kq * 256 + kh;
    const int n = n0 + cgp * 32 + i;
    f32x16 acc; for (int r = 0; r < 16; ++r) acc[r] = 0.f;
    const float* sp = src + n + (size_t)(kq * 256 + kh) * ld;
    for (int kb = 0; kb < 256; kb += 32) {
        float bw[16], cv[16];
#pragma unroll
        for (int j = 0; j < 16; ++j) { bw[j] = sp[(size_t)(kb + 2 * j) * ld]; cv[j] = cptr[kb + 2 * j]; }
#pragma unroll
        for (int j = 0; j < 16; ++j) { const float a = valid ? silu_f(cv[j]) : 0.f; acc = __builtin_amdgcn_mfma_f32_32x32x2f32(a, bw[j], acc, 0, 0, 0); }
    }
    float* red = (float*)smem;
#pragma unroll
    for (int r = 0; r < 16; ++r) red[(wid * 16 + r) * 64 + lane] = acc[r];
    LDS_BARRIER();
    if (kq == 0) {
        const float bv = bias[n];
#pragma unroll
        for (int r = 0; r < 16; ++r) { const int row = (r & 3) + 8 * (r >> 2) + 4 * kh;
            const float s = acc[r] + red[((cgp + 2) * 16 + r) * 64 + lane] + red[((cgp + 4) * 16 + r) * 64 + lane] + red[((cgp + 6) * 16 + r) * 64 + lane];
            if (row < 24) dst[(size_t)row * ld + n] = s + bv; }
    }
    LDS_BARRIER();
}
struct CvtUnit { const float* src; bf16_t* dst; const float* scale; const float* fallback; int ld_src, ldd, ncolrem; };
__device__ __forceinline__ CvtUnit p0_cvt_decode(const Params& p, int idx) {
    CvtUnit c; c.scale = nullptr; c.fallback = p.in[20]; c.ncolrem = 1 << 30; int R0, kk0, k0s, srccol0;
    if (idx < 5632) { const int m = idx / 704, rem = idx % 704, tn = rem >> 3, tk = rem & 7; R0 = 64 * tn; kk0 = 128 * tk; k0s = kk0;
        srccol0 = ((R0 >> 7) & 1) * DFF + 128 * (R0 >> 8) + (R0 & 127); c.src = p.in[9] + (size_t)m * 1024 * 5632; c.ld_src = 5632; c.dst = (bf16_t*)(p.ws + WS_WB1) + (size_t)m * 5632 * 1024; c.ldd = 1024; }
    else if (idx < 8448) { idx -= 5632; const int m = idx / 352, rem = idx % 352, tn = rem / 22, tk = rem % 22; R0 = 64 * tn; kk0 = 128 * tk; k0s = kk0; srccol0 = R0;
        c.src = p.in[10] + (size_t)m * DFF * 1024; c.ld_src = 1024; c.dst = (bf16_t*)(p.ws + WS_WB2) + (size_t)m * 1024 * DFF; c.ldd = DFF; }
    else if (idx < 10880) { idx -= 8448; const int l = idx / 608, rem = idx % 608, tn = rem >> 3, tk = rem & 7; R0 = 64 * tn; kk0 = 128 * tk; k0s = kk0; srccol0 = R0; c.ncolrem = DIN - srccol0;
        c.src = p.in[11] + (size_t)l * 1024 * DIN; c.ld_src = DIN; c.dst = (bf16_t*)(p.ws + WS_WBIN) + (size_t)l * DINP * 1024; c.ldd = 1024; }
    else { idx -= 10880; const int l = idx >> 8, rem = idx & 255, tn = rem >> 4, tk = rem & 15; R0 = 64 * tn; kk0 = 128 * tk; srccol0 = R0;
        if (kk0 < 1024) { k0s = 1024 + kk0; c.scale = p.in[20] + l * 1024 + kk0; } else k0s = kk0 - 1024;
        c.src = p.in[21] + (size_t)l * 2048 * 1024; c.ld_src = 1024; c.dst = (bf16_t*)(p.ws + WS_WBOUT) + (size_t)l * 1024 * 2048; c.ldd = 2048; }
    c.src += (size_t)k0s * c.ld_src + srccol0; c.dst += (size_t)R0 * c.ldd + kk0;
    return c;
}
__device__ __forceinline__ void p0_cvt_load(const CvtUnit& c, int wid, int lane, f32x4 (&v)[4], float (&sc)[2]) {
#pragma unroll
    for (int i = 0; i < 4; ++i) { const int gi = wid + 8 * (i & 1), k = lane + 64 * (i >> 1);
        v[i] = (4 * gi < c.ncolrem) ? *(const f32x4*)(c.src + (size_t)k * c.ld_src + 4 * gi) : (f32x4){0.f, 0.f, 0.f, 0.f}; }
    const float* sp = c.scale ? c.scale : c.fallback; const float s0 = sp[lane], s1 = sp[lane + 64];
    sc[0] = s0; sc[1] = s1;
}
__device__ __forceinline__ void phase0(const Params& p, unsigned char* smem, int tid, int wid, int lane) {
    { bf16_t* wm = (bf16_t*)(p.ws + WS_WM); const float* gw = p.in[13];
      for (int i = blockIdx.x * 512 + tid; i < 4 * 8 * 128 * 128; i += gridDim.x * 512) { const int s = i & 127, t = (i >> 7) & 127; const unsigned w = pk2(gw[i], 0.f); wm[i] = s <= t ? (bf16_t)(w & 0xffffu) : (bf16_t)0; } }
    for (int u = blockIdx.x; u < 608; u += gridDim.x) p0_gemv(p, u, smem, wid, lane);
    bf16_t* tile = (bf16_t*)smem;
    int u = blockIdx.x; CvtUnit cu; f32x4 v[4]; float sc[2];
    bool hs = false;
    if (u < 11904) { cu = p0_cvt_decode(p, u); p0_cvt_load(cu, wid, lane, v, sc); hs = cu.scale != nullptr; }
    while (u < 11904) {
#pragma unroll
        for (int i = 0; i < 4; ++i) { const int gi = wid + 8 * (i & 1), k = lane + 64 * (i >> 1); const float s = hs ? sc[i >> 1] : 1.f;
            const unsigned w0 = pk2(v[i][0] * s, v[i][1] * s), w1 = pk2(v[i][2] * s, v[i][3] * s);
            tile[(4 * gi + 0) * 136 + k] = (bf16_t)(w0 & 0xffffu); tile[(4 * gi + 1) * 136 + k] = (bf16_t)(w0 >> 16);
            tile[(4 * gi + 2) * 136 + k] = (bf16_t)(w1 & 0xffffu); tile[(4 * gi + 3) * 136 + k] = (bf16_t)(w1 >> 16); }
        bf16_t* dst = cu.dst; const int ldd = cu.ldd;
        const int un = u + gridDim.x;
        if (un < 11904) { cu = p0_cvt_decode(p, un); p0_cvt_load(cu, wid, lane, v, sc); hs = cu.scale != nullptr; }
        LDS_BARRIER();
#pragma unroll
        for (int i = 0; i < 2; ++i) { const int id = tid + 512 * i, n = id >> 4, c8 = (id & 15) * 8; const u32x4 w = *(const u32x4*)(tile + n * 136 + c8); *(u32x4*)(dst + (size_t)n * ldd + c8) = w; }
        LDS_BARRIER();
        u = un;
    }
}

template <bool FINAL> __device__ __forceinline__ void norm_phase(const Params& p, int l, int j, bool first, const bf16_t* xsrc, bf16_t* xb, int wid, int lane) {
    const float* g = FINAL ? p.in[22] : p.in[8] + (l * 3 + j) * 1024;
    const float* modl = FINAL ? (const float*)(p.ws + WS_MODF) : (const float*)(p.ws + WS_MOD) + (size_t)l * 24 * 9216 + (3 * j) * 1024;
    const int mstride = FINAL ? 2048 : 9216;
    bf16_t* hn = (bf16_t*)(p.ws + WS_A2);
    for (int row0 = (blockIdx.x * 8 + wid) * 2; row0 < MV; row0 += gridDim.x * 16) {
        float v[2][16]; float ss[2];
        const bool f32src = first || row0 >= MP;
#pragma unroll
        for (int q = 0; q < 2; ++q) { const int row = row0 + q;
            if (f32src) { const float* xr = row >= MP ? (first ? p.in[1] + (size_t)(row - MP) * DM : p.out + (size_t)row * DM) : p.in[0] + (size_t)row * DM;
#pragma unroll
                for (int i = 0; i < 2; ++i) { const f32x4 a = *(const f32x4*)(xr + lane * 8 + 512 * i), c4 = *(const f32x4*)(xr + lane * 8 + 512 * i + 4);
                    v[q][8 * i + 0] = a[0]; v[q][8 * i + 1] = a[1]; v[q][8 * i + 2] = a[2]; v[q][8 * i + 3] = a[3]; v[q][8 * i + 4] = c4[0]; v[q][8 * i + 5] = c4[1]; v[q][8 * i + 6] = c4[2]; v[q][8 * i + 7] = c4[3]; }
            } else {
#pragma unroll
                for (int i = 0; i < 2; ++i) { const u32x4 w = *(const u32x4*)(xsrc + (size_t)row * DM + lane * 8 + 512 * i);
                    v[q][8 * i + 0] = bflo(w.x); v[q][8 * i + 1] = bfhi(w.x); v[q][8 * i + 2] = bflo(w.y); v[q][8 * i + 3] = bfhi(w.y); v[q][8 * i + 4] = bflo(w.z); v[q][8 * i + 5] = bfhi(w.z); v[q][8 * i + 6] = bflo(w.w); v[q][8 * i + 7] = bfhi(w.w); }
            } }
#pragma unroll
        for (int q = 0; q < 2; ++q) { float s = 0.f;
#pragma unroll
            for (int e = 0; e < 16; ++e) s += v[q][e] * v[q][e];
            ss[q] = wave_sum(s); }
#pragma unroll
        for (int q = 0; q < 2; ++q) { const int row = row0 + q;
            const float rinv = rsqrtf(ss[q] * (1.f / 1024.f) + 1e-6f);
            const float* sh = modl + (size_t)modrow(row) * mstride; const float* sc = sh + 1024;
#pragma unroll
            for (int i = 0; i < 2; ++i) {
                const int c = lane * 8 + 512 * i; float o[8];
#pragma unroll
                for (int hh = 0; hh < 2; ++hh) { const f32x4 gg = *(const f32x4*)(g + c + 4 * hh), s4 = *(const f32x4*)(sc + c + 4 * hh), h4 = *(const f32x4*)(sh + c + 4 * hh);
#pragma unroll
                    for (int e = 0; e < 4; ++e) o[4 * hh + e] = (v[q][8 * i + 4 * hh + e] * rinv * gg[e]) * (1.f + s4[e]) + h4[e]; }
                if (FINAL) { *(f32x4*)(p.out + (size_t)row * DM + c) = (f32x4){o[0], o[1], o[2], o[3]}; *(f32x4*)(p.out + (size_t)row * DM + c + 4) = (f32x4){o[4], o[5], o[6], o[7]}; }
                else { *(u32x4*)(hn + (size_t)row * DM + c) = (u32x4){pk2(o[0], o[1]), pk2(o[2], o[3]), pk2(o[4], o[5]), pk2(o[6], o[7])};
                    if (first) { if (row >= MP) { *(f32x4*)(p.out + (size_t)row * DM + c) = (f32x4){v[q][8 * i], v[q][8 * i + 1], v[q][8 * i + 2], v[q][8 * i + 3]}; *(f32x4*)(p.out + (size_t)row * DM + c + 4) = (f32x4){v[q][8 * i + 4], v[q][8 * i + 5], v[q][8 * i + 6], v[q][8 * i + 7]}; }
                                 else *(u32x4*)(xb + (size_t)row * DM + c) = (u32x4){pk2(v[q][8 * i], v[q][8 * i + 1]), pk2(v[q][8 * i + 2], v[q][8 * i + 3]), pk2(v[q][8 * i + 4], v[q][8 * i + 5]), pk2(v[q][8 * i + 6], v[q][8 * i + 7])}; } }
            } }
    }
}

__device__ __forceinline__ void ld8(const bf16_t* q, float (&o)[8]) { const u32x4 w = *(const u32x4*)q; o[0] = bflo(w.x); o[1] = bfhi(w.x); o[2] = bflo(w.y); o[3] = bfhi(w.y); o[4] = bflo(w.z); o[5] = bfhi(w.z); o[6] = bflo(w.w); o[7] = bfhi(w.w); }
__device__ __forceinline__ void conv_unit(const Params& p, int l, int cu, int tid) {
    if (tid >= 384) return;
    int R0, nrows, sb = 0, ch = 0, b = 0; const bool sample = cu >= 512;
    if (!sample) { b = cu >> 5; ch = cu & 31; R0 = b * 2048 + 64 * ch; nrows = 64; } else { sb = cu - 512; R0 = MP + 16 * sb; nrows = 16; }
    const int cgi = tid % 192, half = tid / 192, c0 = cgi * 8, nr = nrows >> 1, t0 = half * nr;
    const bf16_t* proj = (const bf16_t*)(p.ws + WS_PROJ);
    bf16_t* a2 = (bf16_t*)(p.ws + WS_A2); bf16_t* bc = (bf16_t*)(p.ws + WS_BC);
    float w[4][8], bs[8], r0[8], r1[8], r2[8], cur[8];
#pragma unroll
    for (int k = 0; k < 4; ++k)
#pragma unroll
        for (int e = 0; e < 8; ++e) w[k][e] = p.in[15][(size_t)(l * 4 + k) * 1536 + c0 + e];
#pragma unroll
    for (int e = 0; e < 8; ++e) bs[e] = p.in[16][l * 1536 + c0 + e];
#pragma unroll
    for (int hh = 0; hh < 3; ++hh) {
        const int t = t0 - 3 + hh; float tmp[8];
        if (t >= 0 || (!sample && ch > 0)) ld8(proj + (size_t)(R0 + t) * PROJW + 3072 + c0, tmp);
        else if (sample) {
#pragma unroll
            for (int e = 0; e < 8; ++e) tmp[e] = p.in[3][(size_t)((l * 8 + sb) * 3 + (3 + t)) * 1536 + c0 + e];
        } else {
#pragma unroll
            for (int e = 0; e < 8; ++e) tmp[e] = 0.f;
        }
#pragma unroll
        for (int e = 0; e < 8; ++e) { if (hh == 0) r0[e] = tmp[e]; else if (hh == 1) r1[e] = tmp[e]; else r2[e] = tmp[e]; }
    }
    u32x4 raw[4], rawn[4];
#pragma unroll
    for (int q = 0; q < 4; ++q) raw[q] = *(const u32x4*)(proj + (size_t)(R0 + t0 + q) * PROJW + 3072 + c0);
#pragma unroll 1
    for (int tb = t0; tb < t0 + nr; tb += 4) {
        if (tb + 4 < t0 + nr) {
#pragma unroll
            for (int q = 0; q < 4; ++q) rawn[q] = *(const u32x4*)(proj + (size_t)(R0 + tb + 4 + q) * PROJW + 3072 + c0);
        }
#pragma unroll
        for (int q = 0; q < 4; ++q) {
            const int t = tb + q; const u32x4 w4 = raw[q];
            cur[0] = bflo(w4.x); cur[1] = bfhi(w4.x); cur[2] = bflo(w4.y); cur[3] = bfhi(w4.y); cur[4] = bflo(w4.z); cur[5] = bfhi(w4.z); cur[6] = bflo(w4.w); cur[7] = bfhi(w4.w);
            float y[8];
#pragma unroll
            for (int e = 0; e < 8; ++e) { const float a = bs[e] + w[0][e] * r0[e] + w[1][e] * r1[e] + w[2][e] * r2[e] + w[3][e] * cur[e]; y[e] = silu_f(a); }
            const u32x4 o = {pk2(y[0], y[1]), pk2(y[2], y[3]), pk2(y[4], y[5]), pk2(y[6], y[7])};
            if (c0 < 1024) *(u32x4*)(a2 + (size_t)(R0 + t) * 2048 + c0) = o; else *(u32x4*)(bc + (size_t)(R0 + t) * 512 + (c0 - 1024)) = o;
            int k = -1;
            if (!sample) { if (ch == 31 && t >= 61) k = t - 61; } else if (t >= 13) k = t - 13;
            if (k >= 0) { float* op = sample ? p.out + O_CONVS + (size_t)((l * 8 + sb) * 3 + k) * 1536 + c0 : p.out + O_CONVP + (size_t)((l * 16 + b) * 3 + k) * 1536 + c0;
                *(f32x4*)op = (f32x4){cur[0], cur[1], cur[2], cur[3]}; *(f32x4*)(op + 4) = (f32x4){cur[4], cur[5], cur[6], cur[7]}; }
#pragma unroll
            for (int e = 0; e < 8; ++e) { r0[e] = r1[e]; r1[e] = r2[e]; r2[e] = cur[e]; }
        }
#pragma unroll
        for (int q = 0; q < 4; ++q) raw[q] = rawn[q];
    }
}
struct GmU { int R0, nrows, h, sb; bool sample; };
__device__ __forceinline__ GmU gm_decode(int gu) { GmU g; g.sample = gu >= 2048; g.sb = 0;
    if (!g.sample) { const int b = gu >> 7, rem = gu & 127; g.h = rem & 7; g.R0 = b * 2048 + 128 * (rem >> 3); g.nrows = 128; } else { const int s = gu - 2048; g.sb = s >> 3; g.h = s & 7; g.R0 = MP + 16 * g.sb; g.nrows = 16; }
    return g; }
__device__ __forceinline__ void gm_load_v(const bf16_t* proj, const GmU& g, int tid, u32x4 (&vr)[4]) {
    const int i = tid >> 2, d0 = (tid & 3) * 32;
#pragma unroll
    for (int c4 = 0; c4 < 4; ++c4) vr[c4] = i < g.nrows ? *(const u32x4*)(proj + (size_t)(g.R0 + i) * PROJW + 1024 + g.h * 128 + d0 + 8 * c4) : (u32x4){0u, 0u, 0u, 0u};
}
__device__ __forceinline__ void gm_load_u(const bf16_t* proj, const GmU& g, int wid, int lane, u32x2 (&uw)[8]) {
    const int fr = lane & 15, fq = lane >> 4, t = 16 * wid + fr;
#pragma unroll
    for (int d = 0; d < 8; ++d) uw[d] = (16 * wid < g.nrows) ? *(const u32x2*)(proj + (size_t)(g.R0 + t) * PROJW + g.h * 128 + 16 * d + 4 * fq) : (u32x2){0u, 0u};
}
__device__ __forceinline__ void gmlp_units(const Params& p, int l, unsigned char* smem, int tid, int wid, int lane) {
    bf16_t* vnT = (bf16_t*)smem;
    const bf16_t* proj = (const bf16_t*)(p.ws + WS_PROJ);
    int gu = blockIdx.x; if (gu >= 2112) return;
    GmU g = gm_decode(gu); u32x4 vr[4]; u32x2 uw[8];
    gm_load_v(proj, g, tid, vr); gm_load_u(proj, g, wid, lane, uw);
    for (;;) {
        const int R0 = g.R0, nrows = g.nrows, h = g.h, sb = g.sb; const bool sample = g.sample;
        {
            const int i = tid >> 2, q = tid & 3, d0 = q * 32;
            if (i < nrows) {
                float v[32];
#pragma unroll
                for (int c4 = 0; c4 < 4; ++c4) { const u32x4 w4 = vr[c4];
                    v[8 * c4 + 0] = gelu_t(bflo(w4.x)); v[8 * c4 + 1] = gelu_t(bfhi(w4.x)); v[8 * c4 + 2] = gelu_t(bflo(w4.y)); v[8 * c4 + 3] = gelu_t(bfhi(w4.y));
                    v[8 * c4 + 4] = gelu_t(bflo(w4.z)); v[8 * c4 + 5] = gelu_t(bfhi(w4.z)); v[8 * c4 + 6] = gelu_t(bflo(w4.w)); v[8 * c4 + 7] = gelu_t(bfhi(w4.w)); }
                float s = 0.f;
#pragma unroll
                for (int e = 0; e < 32; ++e) s += v[e];
                s = quad_sum(s);
                const float mu = s * (1.f / 128.f);
                float q2 = 0.f;
#pragma unroll
                for (int e = 0; e < 32; ++e) { v[e] -= mu; q2 += v[e] * v[e]; }
                q2 = quad_sum(q2);
                const float rs = rsqrtf(q2 * (1.f / 128.f) + 1e-6f);
                const float* ng = p.in[12] + l * 1024 + h * 128 + d0;
#pragma unroll
                for (int e = 0; e < 32; ++e) v[e] = v[e] * rs * ng[e];
#pragma unroll
                for (int e = 0; e < 32; e += 2) { const unsigned w = pk2(v[e], v[e + 1]); vnT[(d0 + e) * 144 + i] = (bf16_t)(w & 0xffffu); vnT[(d0 + e + 1) * 144 + i] = (bf16_t)(w >> 16); }
                if (sample) { float* gv = p.out + O_GMV + (size_t)((l * 8 + sb) * 16 + i) * 1024 + h * 128 + d0;
#pragma unroll
                    for (int e = 0; e < 32; e += 4) *(f32x4*)(gv + e) = (f32x4){v[e], v[e + 1], v[e + 2], v[e + 3]}; }
            } else if (i < 32) {
#pragma unroll
                for (int e = 0; e < 32; ++e) vnT[(d0 + e) * 144 + i] = (bf16_t)0;
            }
        }
        const int gn = gu + gridDim.x; const bool more = gn < 2112;
        if (more) { g = gm_decode(gn); gm_load_v(proj, g, tid, vr); }
        LDS_BARRIER();
        if (16 * wid < nrows) {
            const int fr = lane & 15, fq = lane >> 4, tt = 16 * wid, nk = ((tt + 15) >> 5) + 1;
            f32x4 acc[8];
#pragma unroll
            for (int d = 0; d < 8; ++d) acc[d] = (f32x4){0.f, 0.f, 0.f, 0.f};
            const bf16_t* wm = (const bf16_t*)(p.ws + WS_WM) + (size_t)((l * 8 + h) * 128 + tt + fr) * 128 + 8 * fq;
            for (int kk = 0; kk < nk; ++kk) {
                const bf16x8 bfr = *(const bf16x8*)(wm + 32 * kk);
#pragma unroll
                for (int d = 0; d < 8; ++d) { const bf16x8 afr = *(const bf16x8*)(vnT + (16 * d + fr) * 144 + 32 * kk + 8 * fq); acc[d] = __builtin_amdgcn_mfma_f32_16x16x32_bf16(afr, bfr, acc[d], 0, 0, 0); }
            }
            const int t = tt + fr; const float bias = p.in[14][(l * 8 + h) * 128 + t];
            bf16_t* a2 = (bf16_t*)(p.ws + WS_A2);
#pragma unroll
            for (int d = 0; d < 8; ++d) {
                const int dcol = h * 128 + 16 * d + 4 * fq;
                const float o0 = gelu_t(bflo(uw[d].x)) * (acc[d][0] + bias), o1 = gelu_t(bfhi(uw[d].x)) * (acc[d][1] + bias), o2 = gelu_t(bflo(uw[d].y)) * (acc[d][2] + bias), o3 = gelu_t(bfhi(uw[d].y)) * (acc[d][3] + bias);
                *(u32x2*)(a2 + (size_t)(R0 + t) * 2048 + 1024 + dcol) = (u32x2){pk2(o0, o1), pk2(o2, o3)};
            }
        }
        if (!more) { LDS_BARRIER(); break; }
        gm_load_u(proj, g, wid, lane, uw);
        LDS_BARRIER();
        gu = gn;
    }
}

__device__ __forceinline__ unsigned tr_addr(unsigned base_b, int stride, int k0, int R0, int lane) {
    const int fq = lane >> 4, i = lane & 15; return base_b + (unsigned)(((k0 + 8 * fq + (i >> 2)) * stride + R0 + 4 * (i & 3)) * 2);
}
#define TR_READ2(lo, hi, addr, stride) asm volatile("ds_read_b64_tr_b16 %0, %2\n\tds_read_b64_tr_b16 %1, %2 offset:%3" : "=&v"(lo), "=&v"(hi) : "v"(addr), "n"(4 * (stride) * 2) : "memory")
#define TR_FRAG(lo, hi) ((bf16x8)__builtin_bit_cast(bf16x8, (u32x4){(lo).x, (lo).y, (hi).x, (hi).y}))

__device__ __forceinline__ void ssd_unit(const Params& p, int l, int su, unsigned char* smem, int tid, int wid, int lane, bool ystore) {
    int RB, nch, nL, h; const float* h0 = nullptr; float* hout;
    if (su < 256) { const int b = su >> 4; h = su & 15; RB = b * 2048; nch = 32; nL = 64; hout = p.out + O_SSMP + (size_t)((l * 16 + b) * 16 + h) * 8192; }
    else { const int s = su - 256, sb = s >> 4; h = s & 15; RB = MP + 16 * sb; nch = 1; nL = 16; h0 = p.in[2] + (size_t)((l * 8 + sb) * 16 + h) * 8192; hout = p.out + O_SSMS + (size_t)((l * 8 + sb) * 16 + h) * 8192; }
    const int g = h >> 3, fr = lane & 15, fq = lane >> 4;
    bf16_t* Cs = (bf16_t*)smem; bf16_t* Bs = Cs + 64 * 144; bf16_t* Hb = Bs + 64 * 144; bf16_t* BT = Hb + 64 * 144; bf16_t* XT = BT + 128 * 80; bf16_t* XdT = XT + 64 * 80; bf16_t* Gs = XdT + 64 * 80;
    bf16_t* Zs = Gs + 64 * 80; bf16_t* Xs = Zs + 64 * 80; float* acs = (float*)(Xs + 64 * 80); float* dts = acs + 64; float* ssq2 = dts + 64;
    const bf16_t* proj = (const bf16_t*)(p.ws + WS_PROJ); const bf16_t* bc = (const bf16_t*)(p.ws + WS_BC); bf16_t* a2 = (bf16_t*)(p.ws + WS_A2);
    const unsigned xs_b = (unsigned)((unsigned char*)Xs - smem), bs_b = (unsigned)((unsigned char*)Bs - smem), xd_b = (unsigned)((unsigned char*)XdT - smem);
    const float* dtraw = (const float*)(p.ws + WS_DT); float* ssq = (float*)(p.ws + WS_SSQ);
    const float dtb = p.in[17][l * 16 + h], aneg = -__expf(p.in[18][l * 16 + h]), dsk = p.in[19][l * 16 + h];
    f32x4 st[4];
#pragma unroll
    for (int pt = 0; pt < 4; ++pt) st[pt] = h0 ? *(const f32x4*)(h0 + (size_t)(16 * pt + fr) * 128 + 16 * wid + 4 * fq) : (f32x4){0.f, 0.f, 0.f, 0.f};
    u32x4 px, pz, pb[2], pc[2]; float pdt;
    const int xrow = lane, xseg = wid;
#define SSD_LOAD(R0) do { const u32x4 z4 = {0u, 0u, 0u, 0u}; \
        px = xrow < nL ? *(const u32x4*)(a2 + (size_t)((R0) + xrow) * 2048 + h * 64 + xseg * 8) : z4; \
        pz = xrow < nL ? *(const u32x4*)(proj + (size_t)((R0) + xrow) * PROJW + 2048 + h * 64 + xseg * 8) : z4; \
        _Pragma("unroll") for (int i = 0; i < 2; ++i) { const int row = lane, seg = wid + 8 * i; \
            pb[i] = row < nL ? *(const u32x4*)(bc + (size_t)((R0) + row) * 512 + g * 128 + seg * 8) : z4; \
            pc[i] = row < nL ? *(const u32x4*)(bc + (size_t)((R0) + row) * 512 + 256 + g * 128 + seg * 8) : z4; } \
        pdt = lane < nL ? dtraw[(size_t)((R0) + lane) * 16 + h] : 0.f; } while (0)
    SSD_LOAD(RB);
    for (int c = 0; c < nch; ++c) {
        const int R0 = RB + 64 * c;
        *(u32x4*)(Xs + xrow * 80 + xseg * 8) = px; *(u32x4*)(Zs + xrow * 80 + xseg * 8) = pz;
#pragma unroll
        for (int i = 0; i < 2; ++i) { const int row = lane, seg = wid + 8 * i;
            *(u32x4*)(Bs + row * 144 + seg * 8) = pb[i]; *(u32x4*)(Cs + row * 144 + seg * 8) = pc[i];
        }
#pragma unroll
        for (int pt = 0; pt < 4; ++pt) *(u32x2*)(Hb + (16 * pt + fr) * 144 + 16 * wid + 4 * fq) = (u32x2){pk2(st[pt][0], st[pt][1]), pk2(st[pt][2], st[pt][3])};
        { const float dtv = lane < nL ? softplus_f(pdt + dtb) : 0.f; float ac = dtv * aneg;
#define DPP_ADD(ctrl, rmask) ac += __int_as_float(__builtin_amdgcn_update_dpp(0, __float_as_int(ac), ctrl, rmask, 0xf, true))
          DPP_ADD(0x111, 0xf); DPP_ADD(0x112, 0xf); DPP_ADD(0x114, 0xf); DPP_ADD(0x118, 0xf); DPP_ADD(0x142, 0xa); DPP_ADD(0x143, 0xc);
#undef DPP_ADD
          if (wid == 0) { acs[lane] = ac; dts[lane] = dtv; }
          const float wgt = __expf(__int_as_float(__builtin_amdgcn_readlane(__float_as_int(ac), 63)) - ac) * dtv;
          *(u32x4*)(XdT + xrow * 80 + xseg * 8) = (u32x4){pk2(bflo(px.x) * wgt, bfhi(px.x) * wgt), pk2(bflo(px.y) * wgt, bfhi(px.y) * wgt), pk2(bflo(px.z) * wgt, bfhi(px.z) * wgt), pk2(bflo(px.w) * wgt, bfhi(px.w) * wgt)}; }
        if (c + 1 < nch) SSD_LOAD(R0 + 64);
        LDS_BARRIER();
        const float acL = acs[63];
        { const int lt = wid >> 1;
#pragma unroll
          for (int q = 0; q < 2; ++q) { const int stl = 2 * (wid & 1) + q; const int lrow = 16 * lt + fr, s0 = 16 * stl + 4 * fq;
              u32x2 o = {0u, 0u};
              if (stl <= lt) {
                  f32x4 acc = {0.f, 0.f, 0.f, 0.f};
#pragma unroll
                  for (int kk = 0; kk < 4; ++kk) { const bf16x8 a = *(const bf16x8*)(Bs + (16 * stl + fr) * 144 + 32 * kk + 8 * fq), b = *(const bf16x8*)(Cs + (16 * lt + fr) * 144 + 32 * kk + 8 * fq); acc = __builtin_amdgcn_mfma_f32_16x16x32_bf16(a, b, acc, 0, 0, 0); }
                  const float al = acs[lrow]; const f32x4 as4 = *(const f32x4*)(acs + s0), dt4 = *(const f32x4*)(dts + s0);
                  float gg[4];
#pragma unroll
                  for (int r = 0; r < 4; ++r) gg[r] = (s0 + r <= lrow) ? acc[r] * __expf(al - as4[r]) * dt4[r] : 0.f;
                  o = (u32x2){pk2(gg[0], gg[1]), pk2(gg[2], gg[3])};
              }
              *(u32x2*)(Gs + lrow * 80 + s0) = o; } }
        LDS_BARRIER();
        { const int lt = wid >> 1, lrow = 16 * lt + fr; const float el = __expf(acs[lrow]); float sq = 0.f;
#pragma unroll
          for (int q = 0; q < 2; ++q) { const int pt = 2 * (wid & 1) + q, p0 = 16 * pt + 4 * fq;
              f32x4 ad = {0.f, 0.f, 0.f, 0.f}, ao = {0.f, 0.f, 0.f, 0.f};
              { u32x2 t0, t1, t2, t3; const unsigned ax = tr_addr(xs_b, 80, 0, 16 * pt, lane);
                TR_READ2(t0, t1, ax, 80); TR_READ2(t2, t3, ax + 32 * 80 * 2, 80);
                const bf16x8 b0 = *(const bf16x8*)(Gs + lrow * 80 + 8 * fq), b1 = *(const bf16x8*)(Gs + lrow * 80 + 32 + 8 * fq);
                asm volatile("s_waitcnt lgkmcnt(0)" : "+v"(t0), "+v"(t1), "+v"(t2), "+v"(t3) :: "memory");
                ad = __builtin_amdgcn_mfma_f32_16x16x32_bf16(TR_FRAG(t0, t1), b0, ad, 0, 0, 0); ad = __builtin_amdgcn_mfma_f32_16x16x32_bf16(TR_FRAG(t2, t3), b1, ad, 0, 0, 0); }
#pragma unroll
              for (int kk = 0; kk < 4; ++kk) { const bf16x8 a = *(const bf16x8*)(Hb + (16 * pt + fr) * 144 + 32 * kk + 8 * fq), b = *(const bf16x8*)(Cs + lrow * 144 + 32 * kk + 8 * fq); ao = __builtin_amdgcn_mfma_f32_16x16x32_bf16(a, b, ao, 0, 0, 0); }
              const u32x2 xw = *(const u32x2*)(Xs + lrow * 80 + p0), zw = *(const u32x2*)(Zs + lrow * 80 + p0);
              const float xv[4] = {bflo(xw.x), bfhi(xw.x), bflo(xw.y), bfhi(xw.y)}, zv[4] = {bflo(zw.x), bfhi(zw.x), bflo(zw.y), bfhi(zw.y)};
              float y[4];
#pragma unroll
              for (int r = 0; r < 4; ++r) { y[r] = (ad[r] + el * ao[r] + dsk * xv[r]) * silu_f(zv[r]); sq += y[r] * y[r]; }
              if (lrow < nL && ystore) *(u32x2*)(a2 + (size_t)(R0 + lrow) * 2048 + h * 64 + p0) = (u32x2){pk2(y[0], y[1]), pk2(y[2], y[3])}; }
          ssq2[lrow * 8 + (wid & 1) * 4 + fq] = sq; }
        { const float eL = __expf(acL);
          u32x2 a0, a1, a2, a3, x0[4], x1[4], x2[4], x3[4];
          const unsigned ab = tr_addr(bs_b, 144, 0, 16 * wid, lane), xb0 = tr_addr(xd_b, 80, 0, 0, lane);
          TR_READ2(a0, a1, ab, 144); TR_READ2(a2, a3, ab + 32 * 144 * 2, 144);
#pragma unroll
          for (int pt = 0; pt < 4; ++pt) { TR_READ2(x0[pt], x1[pt], xb0 + 16 * pt * 2, 80); TR_READ2(x2[pt], x3[pt], xb0 + 16 * pt * 2 + 32 * 80 * 2, 80); }
          asm volatile("s_waitcnt lgkmcnt(0)" : "+v"(a0), "+v"(a1), "+v"(a2), "+v"(a3), "+v"(x0[0]), "+v"(x1[0]), "+v"(x2[0]), "+v"(x3[0]), "+v"(x0[1]), "+v"(x1[1]), "+v"(x2[1]), "+v"(x3[1]),
                       "+v"(x0[2]), "+v"(x1[2]), "+v"(x2[2]), "+v"(x3[2]), "+v"(x0[3]), "+v"(x1[3]), "+v"(x2[3]), "+v"(x3[3]) :: "memory");
#pragma unroll
          for (int pt = 0; pt < 4; ++pt) { f32x4 acc = {0.f, 0.f, 0.f, 0.f};
              acc = __builtin_amdgcn_mfma_f32_16x16x32_bf16(TR_FRAG(a0, a1), TR_FRAG(x0[pt], x1[pt]), acc, 0, 0, 0);
              acc = __builtin_amdgcn_mfma_f32_16x16x32_bf16(TR_FRAG(a2, a3), TR_FRAG(x2[pt], x3[pt]), acc, 0, 0, 0);
              st[pt] = eL * st[pt] + acc; } }
        LDS_BARRIER();
        if (tid < nL) { const f32x4 q0 = *(const f32x4*)(ssq2 + tid * 8), q1 = *(const f32x4*)(ssq2 + tid * 8 + 4); ssq[(size_t)(R0 + tid) * 16 + h] = (q0[0] + q0[1]) + (q0[2] + q0[3]) + (q1[0] + q1[1]) + (q1[2] + q1[3]); }
    }
#undef SSD_LOAD
#pragma unroll
    for (int pt = 0; pt < 4; ++pt) *(f32x4*)(hout + (size_t)(16 * pt + fr) * 128 + 16 * wid + 4 * fq) = st[pt];
    LDS_BARRIER();
}

__global__ void __launch_bounds__(512, 2) mk_fwd(Params p) {
    extern __shared__ __attribute__((aligned(16))) unsigned char smem[];
    cg::grid_group grid = cg::this_grid();
    volatile LAS unsigned* xst = (volatile LAS unsigned*)(smem + 131072 + 3072);
    if (threadIdx.x == 0) { xst[0] = 0u; xst[1] = 0u; }
    __syncthreads();
    const XcdBarrier xb = xcd_barrier_post((unsigned*)(p.ws + WS_BAR), xst);
    for (int ph = p.ph_lo; ph < p.ph_hi; ++ph) {
        if (ph > p.ph_lo) {
            if (ph == p.ph_lo + 1) grid.sync(); else xcd_barrier(xb);
#if defined(PROBE_DUP) && (PROBE_DUP & 32)
            xcd_barrier(xb);
#endif
        }
        const int l = ph == 0 ? 0 : (ph - 1) / 11, s = ph == 0 ? 100 : (ph == NPH - 1 ? 101 : (ph - 1) % 11);
        int nrep = 1;
#if defined(PROBE_DUP)
        if ((PROBE_DUP & 1) && s == 100) nrep = 2;
        if ((PROBE_DUP & 2) && (s == 0 || s == 3 || s == 8)) nrep = 2;
        if ((PROBE_DUP & 4) && (s == 1 || s == 9)) nrep = 2;
        if ((PROBE_DUP & 8) && s == 4) nrep = 2;
        if ((PROBE_DUP & 16) && s == 5) nrep = 2;
        if ((PROBE_DUP & 64) && (s == 2 || s == 10)) nrep = 2;
        if ((PROBE_DUP & 128) && s == 7) nrep = 2;
        if ((PROBE_DUP & 256) && s == 6) nrep = 2;
#endif
      for (int rep = 0; rep < nrep; ++rep) {
        if (rep) xcd_barrier(xb);
        int tid_raw = threadIdx.x; asm volatile("" : "+v"(tid_raw));
        const int tid = tid_raw, wid = __builtin_amdgcn_readfirstlane(tid >> 6), lane = tid & 63;
        if (s == 100) {
#ifndef SKIP_P0
            phase0(p, smem, tid, wid, lane);
#endif
            continue; }
        if (s == 101) {
#ifndef SKIP_NORM
            norm_phase<true>(p, 0, 0, false, (const bf16_t*)(p.ws + WS_A2), nullptr, wid, lane);
#endif
            continue; }
        const float* modl = (const float*)(p.ws + WS_MOD) + (size_t)l * 24 * 9216;
        bf16_t* xb = (bf16_t*)((unsigned char*)p.out + 67108864);
        if (s == 0 || s == 3 || s == 8) {
#ifndef SKIP_NORM
 norm_phase<false>(p, l, s == 0 ? 0 : (s == 3 ? 1 : 2), ph == 1, xb, xb, wid, lane);
#endif
 }
        else if (s == 1 || s == 9) { const int j = s == 9;
            pg8::Gemm g{(const bf16_t*)(p.ws + WS_A2), (const bf16_t*)(p.ws + WS_WB1) + (size_t)(l * 2 + j) * 5632 * 1024, MP, 5632, 1024};
            pg8::StaticOrder S; S.init(g.M, g.N, (int)gridDim.x, (int)blockIdx.x);
            EpiSwiglu E{(bf16_t*)(p.ws + WS_PROJ), 0};
#ifndef SKIP_G1
            sg_g1(p, l, j, wid, lane);
            pg8::gemm_phase<EpiSwiglu, pg8::StaticOrder, false>((PG8_LAS unsigned char*)smem, g, S, E, nullptr);
#endif
 }
        else if (s == 2 || s == 10) { const int j = s == 10;
            pg8::Gemm g{(const bf16_t*)(p.ws + WS_PROJ), (const bf16_t*)(p.ws + WS_WB2) + (size_t)(l * 2 + j) * 1024 * DFF, MP, 1024, DFF};
            pg8::StaticOrder S; S.init(g.M, g.N, (int)gridDim.x, (int)blockIdx.x);
            EpiResid<false> E{(l == 3 && j == 1 && rep + 1 == nrep) ? (bf16_t*)(p.ws + WS_A2) : xb, xb, modl + (j ? 8 : 2) * 1024, (rep + 1 < nrep) ? 0.f : 0.5f, nullptr, 0};
#ifndef SKIP_G2
            sg_resid(p, g.A, DFF, g.Bt, E.gate, E.coef, nullptr, wid, lane);
            pg8::gemm_phase<EpiResid<false>, pg8::StaticOrder, false>((PG8_LAS unsigned char*)smem, g, S, E, nullptr);
#endif
 }
        else if (s == 4) {
            pg8::Gemm g{(const bf16_t*)(p.ws + WS_A2), (const bf16_t*)(p.ws + WS_WBIN) + (size_t)l * DINP * 1024, MP, PROJW, 1024};
            pg8::StaticOrder S; S.init(g.M, g.N, (int)gridDim.x, (int)blockIdx.x);
            EpiProj E{(bf16_t*)(p.ws + WS_PROJ), nullptr, 0};
#ifndef SKIP_GIN
            sg_in(p, l, wid, lane);
            pg8::gemm_phase<EpiProj, pg8::StaticOrder, false>((PG8_LAS unsigned char*)smem, g, S, E, nullptr);
#endif
 }
        else if (s == 5) {
#ifndef SKIP_MIXA
#ifndef SKIP_GM
            gmlp_units(p, l, smem, tid, wid, lane);
#endif
#ifndef SKIP_CONV
            for (int u = blockIdx.x; u < 520; u += gridDim.x) conv_unit(p, l, u, tid);
#endif
#endif
 }
        else if (s == 6) { for (int u = blockIdx.x; u < 384; u += gridDim.x) {
#ifndef SKIP_SSD
 ssd_unit(p, l, u, smem, tid, wid, lane, rep + 1 == nrep);
#endif
 } }
        else {
            pg8::Gemm g{(const bf16_t*)(p.ws + WS_A2), (const bf16_t*)(p.ws + WS_WBOUT) + (size_t)l * 1024 * 2048, MP, 1024, 2048};
            pg8::StaticOrder S; S.init(g.M, g.N, (int)gridDim.x, (int)blockIdx.x);
            float* rl = (float*)(smem + 131072);
            { const float* ssq = (const float*)(p.ws + WS_SSQ);
              for (int i = 0; i < 2; ++i) { pg8::Unit uu; if (!S.next(i, uu)) break;
                  if (tid < 256) { const f32x4* sp = (const f32x4*)(ssq + (size_t)(uu.pm * 256 + tid) * 16); const f32x4 s4 = sp[0] + sp[1] + sp[2] + sp[3];
                      rl[i * 256 + tid] = rsqrtf((s4[0] + s4[1] + s4[2] + s4[3]) * (1.f / 1024.f) + 1e-6f); } }
              __syncthreads(); }
            EpiResid<true> E{xb, xb, modl + 5 * 1024, (rep + 1 < nrep) ? 0.f : 1.0f, rl, 16};
#ifndef SKIP_GOUT
            sg_resid(p, g.A, 2048, g.Bt, E.gate, E.coef, (const float*)(p.ws + WS_SSQ), wid, lane);
            pg8::gemm_phase<EpiResid<true>, pg8::StaticOrder, false>((PG8_LAS unsigned char*)smem, g, S, E, nullptr);
#endif
 }
      }
    }
}

extern "C" void kernel_launch(void* const* d_in, const int* in_sizes, int n_in, void* d_out, int out_size, void* d_ws, size_t ws_size, hipStream_t stream) {
    static int grid = 0;
    if (grid == 0) {
        if (n_in != 25 || ws_size < WS_END) { fprintf(stderr, "kernel_launch: unexpected n_in %d or workspace %zu < %zu\n", n_in, ws_size, (size_t)WS_END); grid = -1; return; }
        int dev = 0, cus = 0, per_cu = 0;
        hipGetDevice(&dev); hipDeviceGetAttribute(&cus, hipDeviceAttributeMultiprocessorCount, dev);
        if (hipFuncSetAttribute((const void*)mk_fwd, hipFuncAttributeMaxDynamicSharedMemorySize, LDS_BYTES) != hipSuccess) { fprintf(stderr, "kernel_launch: hipFuncSetAttribute failed\n"); grid = -1; return; }
        if (hipOccupancyMaxActiveBlocksPerMultiprocessor(&per_cu, (const void*)mk_fwd, 512, LDS_BYTES) != hipSuccess || per_cu < 1) { fprintf(stderr, "kernel_launch: occupancy query gave %d\n", per_cu); per_cu = 1; (void)hipGetLastError(); }
        grid = cus * (per_cu > 1 ? 1 : per_cu);
    }
    if (grid < 0) return;
    Params p{};
    for (int i = 0; i < 25; ++i) p.in[i] = (const float*)d_in[i];
    p.out = (float*)d_out; p.ws = (unsigned char*)d_ws;
#if MK_MULTI
    for (int ph = 0; ph < NPH; ++ph) { p.ph_lo = ph; p.ph_hi = ph + 1; hipLaunchKernelGGL(mk_fwd, dim3(grid), dim3(512), LDS_BYTES, stream, p); }
#else
    p.ph_lo = 0; p.ph_hi = NPH;
    if (hipMemsetAsync((unsigned char*)d_ws + WS_BAR, 0, 16384, stream) != hipSuccess) { fprintf(stderr, "kernel_launch: memset of the barrier words failed\n"); return; }
    void* args[] = {&p};
    const hipError_t e = hipLaunchCooperativeKernel((const void*)mk_fwd, dim3(grid), dim3(512), args, LDS_BYTES, stream);
    if (e != hipSuccess) fprintf(stderr, "kernel_launch: cooperative launch failed: %s (grid %d)\n", hipGetErrorString(e), grid);
#endif
}
```

```cpp
#include <hip/hip_runtime.h>
#include <hip/hip_cooperative_groups.h>
#include <cstdio>
namespace cg = cooperative_groups;

#ifndef MK_MULTI
#define MK_MULTI 0
#endif

typedef unsigned short bf16_t;
typedef short bf16x8 __attribute__((ext_vector_type(8)));
typedef float f32x4 __attribute__((ext_vector_type(4)));
typedef float f32x16 __attribute__((ext_vector_type(16)));
typedef unsigned u32x4 __attribute__((ext_vector_type(4)));
typedef unsigned u32x2 __attribute__((ext_vector_type(2)));

constexpr int DM = 1024, MP = 32768  , MV = 32896  , MPAD = 33024  ;
constexpr int DFF = 2816, DIN = 4624, DINP = 4864, PROJW = 4608, NPH = 46;
constexpr int LDS_BYTES = 131072 + 3072 + 16;
constexpr size_t O_YS = 33554432, O_SSMP = 33685504, O_CONVP = 42074112, O_SSMS = 42369024, O_CONVS = 46563328, O_GMV = 46710784;
constexpr size_t WS_WB1 = 0;
constexpr size_t WS_WB2 = WS_WB1 + (size_t)8 * 5632 * 1024 * 2;
constexpr size_t WS_WBIN = WS_WB2 + (size_t)8 * 1024 * 2816 * 2;
constexpr size_t WS_WBOUT = WS_WBIN + (size_t)4 * DINP * 1024 * 2;
constexpr size_t WS_WM = WS_WBOUT + (size_t)4 * 1024 * 2048 * 2;
constexpr size_t WS_MOD = WS_WM + (size_t)4 * 8 * 128 * 128 * 2;
constexpr size_t WS_MODF = WS_MOD + (size_t)4 * 24 * 9216 * 4;
constexpr size_t WS_PROJ = WS_MODF + (size_t)24 * 2048 * 4;
constexpr size_t WS_DT = WS_PROJ + (size_t)MPAD * PROJW * 2;
constexpr size_t WS_BC = WS_DT + (size_t)MPAD * 16 * 4;
constexpr size_t WS_A2 = WS_BC + (size_t)MPAD * 512 * 2;
constexpr size_t WS_SSQ = WS_A2 + (size_t)MPAD * 2048 * 2;
constexpr size_t WS_BAR = WS_SSQ + (size_t)MPAD * 16 * 4;
constexpr size_t WS_END = WS_BAR + 16384;

struct Params { const float* in[25]; float* out; unsigned char* ws; int ph_lo, ph_hi; };

__device__ __forceinline__ float silu_f(float x) { return x * __builtin_amdgcn_rcpf(1.f + __builtin_amdgcn_exp2f(-1.4426950408889634f * x)); }
__device__ __forceinline__ float gelu_t(float x) { const float t = x * x; const float u = x * (-2.3022082f - 0.1029432f * t); return x * __builtin_amdgcn_rcpf(1.f + __builtin_amdgcn_exp2f(u)); }
__device__ __forceinline__ float softplus_f(float x) { return fmaxf(x, 0.f) + __logf(1.f + __expf(-fabsf(x))); }
__device__ __forceinline__ float bflo(unsigned w) { return __uint_as_float(w << 16); }
__device__ __forceinline__ float bfhi(unsigned w) { return __uint_as_float(w & 0xffff0000u); }
__device__ __forceinline__ unsigned pk2(float lo, float hi) { unsigned r; asm volatile("v_cvt_pk_bf16_f32 %0, %1, %2" : "=v"(r) : "v"(lo), "v"(hi)); return r; }
__device__ __forceinline__ int modrow(int row) { int r = row < MP ? (row >> 11) : 16 + ((row - MP) >> 4); return r > 23 ? 23 : r; }

__device__ __forceinline__ float wave_sum(float v) {
#define DPP_ADDV(ctrl, rmask) v += __int_as_float(__builtin_amdgcn_update_dpp(0, __float_as_int(v), ctrl, rmask, 0xf, true))
    DPP_ADDV(0x111, 0xf); DPP_ADDV(0x112, 0xf); DPP_ADDV(0x114, 0xf); DPP_ADDV(0x118, 0xf); DPP_ADDV(0x142, 0xa); DPP_ADDV(0x143, 0xc);
#undef DPP_ADDV
    return __int_as_float(__builtin_amdgcn_readlane(__float_as_int(v), 63));
}
__device__ __forceinline__ float quad_sum(float v) {
    v += __int_as_float(__builtin_amdgcn_update_dpp(0, __float_as_int(v), 0xB1, 0xf, 0xf, true));
    v += __int_as_float(__builtin_amdgcn_update_dpp(0, __float_as_int(v), 0x4E, 0xf, 0xf, true));
    return v;
}
namespace pg8 {
#define PG8_LAS __attribute__((address_space(3)))
typedef unsigned short bf16_t;
typedef short bf16x8 __attribute__((ext_vector_type(8)));
typedef float f32x4 __attribute__((ext_vector_type(4)));
typedef unsigned u32x4 __attribute__((ext_vector_type(4)));
constexpr int BM = 256, BK = 64, HALF = 128, HTB = HALF * BK * 2  , STAGE_BYTES = 8 * HTB, NXCD = 8, WGM = 8;

__host__ __device__ __forceinline__ int lds_byte(int r, int c) { const int st = (r >> 4) * 2 + (c >> 5), rr = r & 15, cc = c & 31, ob = rr * 64 + cc * 2; return st * 1024 + (ob ^ (((ob >> 9) & 1) << 5)); }
__host__ __device__ __forceinline__ void stage_rc(int b, int& R, int& C) { const int st = b / 1024, sb = b % 1024, swz = sb ^ (((sb >> 9) & 1) << 5); R = (st >> 1) * 16 + swz / 64; C = (st & 1) * 32 + (swz % 64) / 2; }
__host__ __device__ __forceinline__ int perm32(int rho) { const int n = rho >> 4, i = rho & 15; return 8 * (i >> 2) + 4 * n + (i & 3); }
struct Unit { int pm, pn; };
struct Gemm { const bf16_t* A; const bf16_t* Bt; int M, N, K; };
struct StaticOrder {
    int nM, nN, nwg, G, c;
    __host__ __device__ void init(int M, int N, int G_, int c_) { nM = M / BM; nN = N / BM; nwg = nM * nN; G = G_; c = c_; }
    __host__ __device__ bool next(int i, Unit& u) const {
        const long L = (long)i * G + c; if (L >= nwg) return false;
        int wgid = (int)L; { const int q = nwg / NXCD, r = nwg % NXCD, xcd = wgid % NXCD, off = wgid / NXCD; wgid = (xcd < r ? xcd * (q + 1) : r * (q + 1) + (xcd - r) * q) + off; }
        const int nig = WGM * nN, gid = wgid / nig, fm = gid * WGM, gsz = (nM - fm) < WGM ? (nM - fm) : WGM;
        u.pm = fm + ((wgid % nig) % gsz); u.pn = (wgid % nig) / gsz; return true;
    }
    __device__ __forceinline__ void a_ready(const Unit&) const {}
    __device__ __forceinline__ void done(const Unit&) const {}
};
__device__ __forceinline__ unsigned cvt_pk_bf16(float lo, float hi) { unsigned r; asm volatile("v_cvt_pk_bf16_f32 %0, %1, %2" : "=v"(r) : "v"(lo), "v"(hi)); return r; }
typedef float f32x2 __attribute__((ext_vector_type(2)));
template <class Epi, class Sched, bool STAMP = false>
__device__ __forceinline__ void gemm_phase(PG8_LAS unsigned char* lds, const Gemm g, const Sched& S, const Epi& E, unsigned long long* stamps) {
    int tid_raw = threadIdx.x; asm volatile("" : "+v"(tid_raw));
    const int tid = tid_raw, wid = __builtin_amdgcn_readfirstlane(tid >> 6), lane = tid & 63, wr = wid >> 2, wc = wid & 3, fr = lane & 15, fq = lane >> 4;
    const int K = g.K, nt = K / BK;
    int ts_lo = 0, ts_hi = 0, nts = 0; const unsigned long long rt_entry = STAMP ? (unsigned long long)wall_clock64() : 0ull;
#define PG8_STAMP() do { if (STAMP && wid == 0 && nts < 64) { const unsigned long long _c = (unsigned long long)clock64(); \
        ts_lo = (lane == nts) ? (int)(unsigned)_c : ts_lo; ts_hi = (lane == nts) ? (int)(unsigned)(_c >> 32) : ts_hi; ++nts; } } while (0)
    PG8_STAMP();
    unsigned voffA[2], voffB[2];
#pragma unroll
    for (int i = 0; i < 2; ++i) { int R, C; stage_rc(tid * 16 + i * 8192, R, C); const int Rb = Epi::PERM ? ((R & ~31) + perm32(R & 31)) : R;
        voffA[i] = (unsigned)(R * K + C) * 2u; voffB[i] = (unsigned)(Rb * K + C) * 2u; }
    const size_t kstep = (size_t)(BK * 2);
    const size_t hstep = (size_t)HALF * K * 2;
    const size_t tstep = 2 * hstep;
    const unsigned ldsw = (unsigned)wid * 1024u;
    const int aoff = lds_byte(wr * 64 + fr, fq * 8), boff = lds_byte(wc * 32 + fr, fq * 8);
#define PG8_SA(b, h) (((b) * 2 + (h)) * HTB)
#define PG8_SB(b, h) ((4 + (b) * 2 + (h)) * HTB)
#define PG8_STAGE(bufoff, gbase, voff) do { _Pragma("unroll") for (int _i = 0; _i < 2; ++_i) \
        __builtin_amdgcn_global_load_lds((const unsigned*)((const char*)(gbase) + (voff)[_i]), (PG8_LAS unsigned*)(lds + (bufoff) + ldsw + _i * 8192), 16, 0, 0); } while (0)
#define PG8_LDA(dst, b, h) do { _Pragma("unroll") for (int m = 0; m < 4; ++m) _Pragma("unroll") for (int k = 0; k < 2; ++k) dst[m][k] = *(const PG8_LAS bf16x8*)(lds + PG8_SA(b, h) + aoff + m * 2048 + k * 1024); } while (0)
#define PG8_LDB(dst, b, h) do { _Pragma("unroll") for (int n = 0; n < 2; ++n) _Pragma("unroll") for (int k = 0; k < 2; ++k) dst[n][k] = *(const PG8_LAS bf16x8*)(lds + PG8_SB(b, h) + boff + n * 2048 + k * 1024); } while (0)
#define PG8_MMA(ai, bj, At, Bt) do { __builtin_amdgcn_s_setprio(1); _Pragma("unroll") for (int m = 0; m < 4; ++m) _Pragma("unroll") for (int n = 0; n < 2; ++n) _Pragma("unroll") for (int k = 0; k < 2; ++k) \
        acc[ai][bj][m][n] = __builtin_amdgcn_mfma_f32_16x16x32_bf16(Bt[n][k], At[m][k], acc[ai][bj][m][n], 0, 0, 0); __builtin_amdgcn_s_setprio(0); } while (0)
#define PG8_WAIT_V(n) asm volatile("s_waitcnt vmcnt(" #n ")" ::: "memory")
#define PG8_WAIT_L(n) asm volatile("s_waitcnt lgkmcnt(" #n ")" ::: "memory")
#define PG8_BAR __builtin_amdgcn_s_barrier()
#define PG8_SCHED __builtin_amdgcn_sched_barrier(0)
    Unit cur, nxt; int ui = 0;
    if (!S.next(0, cur)) return;
    f32x4 acc[2][2][4][2];
#pragma unroll
    for (int a = 0; a < 2; ++a)
#pragma unroll
        for (int b = 0; b < 2; ++b)
#pragma unroll
            for (int m = 0; m < 4; ++m)
#pragma unroll
                for (int n = 0; n < 2; ++n) acc[a][b][m][n] = (f32x4){0.f, 0.f, 0.f, 0.f};
    bf16x8 At[4][2], B0[2][2], B1[2][2];
    const char* cA = (const char*)g.A + (size_t)cur.pm * tstep; const char* cB = (const char*)g.Bt + (size_t)cur.pn * tstep;
    S.a_ready(cur);
    PG8_STAGE(PG8_SB(0, 0), cB, voffB); PG8_STAGE(PG8_SA(0, 0), cA, voffA); PG8_STAGE(PG8_SB(0, 1), cB + hstep, voffB); PG8_STAGE(PG8_SA(0, 1), cA + hstep, voffA);
    if (wr == 1) PG8_BAR;
    PG8_WAIT_V(4); PG8_BAR;
    PG8_STAGE(PG8_SB(1, 0), cB + kstep, voffB); PG8_STAGE(PG8_SA(1, 0), cA + kstep, voffA); PG8_STAGE(PG8_SB(1, 1), cB + hstep + kstep, voffB);
    PG8_WAIT_V(6); PG8_BAR;
    PG8_STAMP();
    for (;;) {
        const bool has_next = S.next(ui + 1, nxt);
        const char* nA = has_next ? (const char*)g.A + (size_t)nxt.pm * tstep : cA; const char* nB = has_next ? (const char*)g.Bt + (size_t)nxt.pn * tstep : cB;
        for (int t = 0; t < nt; t += 2) {
            if constexpr (Epi::MIDK) { if (t == E.midk_t) E.mid(acc, ui, wr, wc, fr, fq); }
            const bool last = (t == nt - 2);
            const char* a1 = cA + (size_t)(t + 1) * kstep;
            const char* a2 = last ? nA : cA + (size_t)(t + 2) * kstep; const char* b2 = last ? nB : cB + (size_t)(t + 2) * kstep;
            const char* a3 = a2 + kstep; const char* b3 = b2 + kstep;
            if (last && has_next) S.a_ready(nxt);
            PG8_LDB(B0, 0, 0); PG8_SCHED; PG8_LDA(At, 0, 0); PG8_STAGE(PG8_SA(1, 1), a1 + hstep, voffA);
            PG8_WAIT_L(8); PG8_BAR; PG8_WAIT_L(0); PG8_MMA(0, 0, At, B0); PG8_BAR; PG8_SCHED;
            PG8_LDB(B1, 0, 1); PG8_STAGE(PG8_SB(0, 0), b2, voffB);
            PG8_BAR; PG8_WAIT_L(0); PG8_MMA(0, 1, At, B1); PG8_BAR;
            PG8_LDA(At, 0, 1); PG8_STAGE(PG8_SA(0, 0), a2, voffA);
            PG8_BAR; PG8_WAIT_L(0); PG8_MMA(1, 0, At, B0); PG8_BAR; PG8_SCHED;
            PG8_STAGE(PG8_SB(0, 1), b2 + hstep, voffB);
            PG8_WAIT_V(6); PG8_BAR; PG8_MMA(1, 1, At, B1); PG8_BAR;
            PG8_LDB(B0, 1, 0); PG8_SCHED; PG8_LDA(At, 1, 0); PG8_STAGE(PG8_SA(0, 1), a2 + hstep, voffA);
            PG8_WAIT_L(8); PG8_BAR; PG8_WAIT_L(0); PG8_MMA(0, 0, At, B0); PG8_BAR; PG8_SCHED;
            PG8_LDB(B1, 1, 1); PG8_STAGE(PG8_SB(1, 0), b3, voffB);
            PG8_BAR; PG8_WAIT_L(0); PG8_MMA(0, 1, At, B1); PG8_BAR;
            PG8_LDA(At, 1, 1); PG8_STAGE(PG8_SA(1, 0), a3, voffA);
            PG8_BAR; PG8_WAIT_L(0); PG8_MMA(1, 0, At, B0); PG8_BAR; PG8_SCHED;
            PG8_STAGE(PG8_SB(1, 1), b3 + hstep, voffB);
            PG8_WAIT_V(6); PG8_BAR; PG8_MMA(1, 1, At, B1); PG8_BAR;
        }
        PG8_STAMP();
        if constexpr (!Epi::AFTER_DRAIN) { E(acc, cur, wr, wc, fr, fq); S.done(cur); }
        PG8_STAMP();
        if (!has_next) break;
#pragma unroll
        for (int a = 0; a < 2; ++a)
#pragma unroll
            for (int b = 0; b < 2; ++b)
#pragma unroll
                for (int m = 0; m < 4; ++m)
#pragma unroll
                    for (int n = 0; n < 2; ++n) acc[a][b][m][n] = (f32x4){0.f, 0.f, 0.f, 0.f};
        cur = nxt; cA = nA; cB = nB; ++ui;
    }
    PG8_WAIT_V(0);
    if (wr == 0) PG8_BAR;
    PG8_BAR;
    if constexpr (Epi::AFTER_DRAIN) { E.fused(acc, cur, wr, wc, fr, fq, lds, wid, lane); S.done(cur); }
    PG8_STAMP();
    if (STAMP && wid == 0) { stamps[lane] = lane < nts ? (((unsigned long long)(unsigned)ts_hi << 32) | (unsigned)ts_lo) : 0ull;
        if (lane == 62) stamps[62] = rt_entry; if (lane == 63) stamps[63] = (unsigned long long)wall_clock64(); }
#undef PG8_STAMP
#undef PG8_SA
#undef PG8_SB
#undef PG8_STAGE
#undef PG8_LDA
#undef PG8_LDB
#undef PG8_MMA
#undef PG8_WAIT_V
#undef PG8_WAIT_L
#undef PG8_BAR
#undef PG8_SCHED
}
}
#define XB_TMO      128
#define XB_XCNT(j)  (256  + 64 * (j))
#define XB_XSUB(j)  (1280 + 64 * (j))
#define XB_XGEN(j)  (2304 + 64 * (j))
#define XB_TOP      3328
#define XB_TOPGEN   3392
#define XCD_BAR_WORDS 3456
#define XB_SPIN_CAP (1u << 18)
#define LAS __attribute__((address_space(3)))

__device__ __forceinline__ unsigned xb_ld(unsigned* p)              { return __hip_atomic_load(p, __ATOMIC_RELAXED, __HIP_MEMORY_SCOPE_AGENT); }
__device__ __forceinline__ unsigned xb_add(unsigned* p, unsigned v) { return __hip_atomic_fetch_add(p, v, __ATOMIC_RELAXED, __HIP_MEMORY_SCOPE_AGENT); }
__device__ __forceinline__ unsigned xb_xcc_id() { return (unsigned)__builtin_amdgcn_s_getreg((3 << 11) | 20) & 0xFu; }
#define XB_SPIN(cond, bar) do { unsigned _sp = 0; while (cond) { __builtin_amdgcn_s_sleep(1); \
    if ((++_sp & 255u) == 0u) { if (xb_ld(&(bar)[XB_TMO])) break; if (_sp > XB_SPIN_CAP) { atomicAdd(&(bar)[XB_TMO], 1u); break; } } } } while (0)

struct XcdBarrier {
    unsigned* bar; unsigned x;
    volatile LAS unsigned* st;
};

__device__ __forceinline__ XcdBarrier xcd_barrier_post(unsigned* bar, volatile LAS unsigned* st) {
    XcdBarrier b; b.bar = bar; b.x = xb_xcc_id(); b.st = st;
    if (threadIdx.x == 0) (void)xb_add(&bar[XB_XCNT(b.x)], 1u);
    return b;
}
__device__ __forceinline__ void xcd_barrier_complete(unsigned* bar, unsigned x, unsigned& nloc, unsigned& nx) {
    const unsigned G = gridDim.x * gridDim.y * gridDim.z;
    unsigned sum, cnt, mine, sp = 0u;
    for (;;) {
        sum = 0u; cnt = 0u; mine = 0u;
#pragma unroll
        for (unsigned j = 0; j < 16; ++j) { const unsigned c = xb_ld(&bar[XB_XCNT(j)]); sum += c; cnt += (c > 0u) ? 1u : 0u; mine = (j == x) ? c : mine; }
        if (sum == G) break;
        __builtin_amdgcn_s_sleep(1);
        if ((++sp & 255u) == 0u) { if (xb_ld(&bar[XB_TMO])) break; if (sp > XB_SPIN_CAP) { atomicAdd(&bar[XB_TMO], 1u); break; } }
    }
    nloc = mine > 0u ? mine : 1u; nx = cnt > 0u ? cnt : 1u;
}

__device__ __forceinline__ void xcd_barrier(const XcdBarrier& b) {
    asm volatile("s_waitcnt vmcnt(0)" ::: "memory");
    __syncthreads();
    if (threadIdx.x == 0) {
        unsigned* bar = b.bar;
        __builtin_amdgcn_s_waitcnt(0);
        unsigned nloc = b.st[0], nx = b.st[1];
        if (nloc == 0u) { xcd_barrier_complete(bar, b.x, nloc, nx); b.st[0] = nloc; b.st[1] = nx; }
        const unsigned old = xb_add(&bar[XB_XSUB(b.x)], 1u);
        const unsigned gen = old / nloc;
        if (old + 1u == (gen + 1u) * nloc) {
            __builtin_amdgcn_fence(__ATOMIC_RELEASE, "agent");
            asm volatile("s_waitcnt vmcnt(0)" ::: "memory");
            const unsigned og = xb_add(&bar[XB_TOP], 1u);
            const unsigned tg = og / nx;
            if (og + 1u == (tg + 1u) * nx) xb_add(&bar[XB_TOPGEN], 1u);
            else XB_SPIN(xb_ld(&bar[XB_TOPGEN]) == tg, bar);
            __builtin_amdgcn_fence(__ATOMIC_ACQUIRE, "agent");
            xb_add(&bar[XB_XGEN(b.x)], 1u);
            asm volatile("s_waitcnt vmcnt(0)" ::: "memory");
        } else {
            XB_SPIN(xb_ld(&bar[XB_XGEN(b.x)]) == gen, bar);
            __builtin_amdgcn_fence(__ATOMIC_ACQUIRE, "agent");
            asm volatile("s_waitcnt vmcnt(0)" ::: "memory");
        }
    }
    __syncthreads();
}
#define LDS_BARRIER() do { asm volatile("s_waitcnt lgkmcnt(0)" ::: "memory"); __builtin_amdgcn_s_barrier(); asm volatile("" ::: "memory"); } while (0)

struct EpiSwiglu {
    static constexpr bool PERM = true, AFTER_DRAIN = false, MIDK = false;
    bf16_t* H; int midk_t;
    __device__ __forceinline__ void operator()(const f32x4 (&acc)[2][2][4][2], const pg8::Unit& u, int wr, int wc, int fr, int fq) const {
        const int row0 = u.pm * 256 + wr * 64 + fr, col0 = u.pn * 128 + wc * 32 + 8 * fq;
#pragma unroll
        for (int ai = 0; ai < 2; ++ai)
#pragma unroll
            for (int m = 0; m < 4; ++m) {
                bf16_t* rowp = H + (size_t)(row0 + ai * 128 + m * 16) * DFF + col0;
                const f32x4 g0 = acc[ai][0][m][0], g1 = acc[ai][0][m][1], u0 = acc[ai][1][m][0], u1 = acc[ai][1][m][1];
                u32x4 w;
                w.x = pk2(silu_f(g0[0]) * u0[0], silu_f(g0[1]) * u0[1]); w.y = pk2(silu_f(g0[2]) * u0[2], silu_f(g0[3]) * u0[3]);
                w.z = pk2(silu_f(g1[0]) * u1[0], silu_f(g1[1]) * u1[1]); w.w = pk2(silu_f(g1[2]) * u1[2], silu_f(g1[3]) * u1[3]);
                *(u32x4*)rowp = w;
            }
    }
};
struct SwapOrder : pg8::StaticOrder {
    __host__ __device__ bool next(int i, pg8::Unit& u) const { const bool ok = pg8::StaticOrder::next(i, u); u.pm ^= 8; return ok; }
};
template <bool MID> struct EpiResid {
    static constexpr bool PERM = true, AFTER_DRAIN = false, MIDK = MID;
    bf16_t* X; const bf16_t* Xin; const float* gate; float coef; const float* rinv; int midk_t;
    __device__ __forceinline__ void operator()(const f32x4 (&acc)[2][2][4][2], const pg8::Unit& u, int wr, int wc, int fr, int fq) const {
        const int col0 = u.pn * 256 + wc * 32 + 8 * fq;
        const float* gp = gate + (size_t)(u.pm >> 3) * 9216 + col0;
        f32x4 gv[2][2];
#pragma unroll
        for (int bj = 0; bj < 2; ++bj)
#pragma unroll
            for (int n = 0; n < 2; ++n) gv[bj][n] = coef * *(const f32x4*)(gp + bj * 128 + 4 * n);
#pragma unroll
        for (int ai = 0; ai < 2; ++ai) {
            u32x4 xw[4][2];
#pragma unroll
            for (int m = 0; m < 4; ++m)
#pragma unroll
                for (int bj = 0; bj < 2; ++bj) xw[m][bj] = *(const u32x4*)(Xin + (size_t)(u.pm * 256 + ai * 128 + wr * 64 + m * 16 + fr) * DM + col0 + bj * 128);
#pragma unroll
            for (int m = 0; m < 4; ++m)
#pragma unroll
                for (int bj = 0; bj < 2; ++bj) { const u32x4 w = xw[m][bj]; const f32x4 a0 = gv[bj][0] * acc[ai][bj][m][0], a1 = gv[bj][1] * acc[ai][bj][m][1];
                    const u32x4 o = {pk2(bflo(w.x) + a0[0], bfhi(w.x) + a0[1]), pk2(bflo(w.y) + a0[2], bfhi(w.y) + a0[3]), pk2(bflo(w.z) + a1[0], bfhi(w.z) + a1[1]), pk2(bflo(w.w) + a1[2], bfhi(w.w) + a1[3])};
                    *(u32x4*)(X + (size_t)(u.pm * 256 + ai * 128 + wr * 64 + m * 16 + fr) * DM + col0 + bj * 128) = o; }
            asm volatile("" ::: "memory");
        }
    }
    __device__ __forceinline__ void mid(f32x4 (&acc)[2][2][4][2], int ui, int wr, int wc, int fr, int fq) const {
        const float* rl = rinv + ui * 256 + wr * 64 + fr;
#pragma unroll
        for (int ai = 0; ai < 2; ++ai)
#pragma unroll
            for (int m = 0; m < 4; ++m) {
                const float r = rl[ai * 128 + m * 16];
#pragma unroll
                for (int bj = 0; bj < 2; ++bj)
#pragma unroll
                    for (int n = 0; n < 2; ++n) acc[ai][bj][m][n] *= r;
            }
    }
};
struct EpiProj {
    static constexpr bool PERM = true, AFTER_DRAIN = false, MIDK = false;
    bf16_t* P; float* DT; int midk_t;
    __device__ __forceinline__ void operator()(const f32x4 (&acc)[2][2][4][2], const pg8::Unit& u, int wr, int wc, int fr, int fq) const {
        const int row0 = u.pm * 256 + wr * 64 + fr;
        {
            const int col0 = u.pn * 256 + wc * 32 + 8 * fq;
#pragma unroll
            for (int ai = 0; ai < 2; ++ai)
#pragma unroll
                for (int m = 0; m < 4; ++m) {
                    bf16_t* rowp = P + (size_t)(row0 + ai * 128 + m * 16) * PROJW + col0;
#pragma unroll
                    for (int bj = 0; bj < 2; ++bj) { const f32x4 v0 = acc[ai][bj][m][0], v1 = acc[ai][bj][m][1]; u32x4 w; w.x = pk2(v0[0], v0[1]); w.y = pk2(v0[2], v0[3]); w.z = pk2(v1[0], v1[1]); w.w = pk2(v1[2], v1[3]); *(u32x4*)(rowp + bj * 128) = w; }
                }
        }
    }
};


__device__ __forceinline__ f32x4 sg_dot(const bf16_t* A, int lda, int row0, const bf16_t* Bt, int ldb, int n0, int k0, int nk, int wid, int lane) {
    const int fr = lane & 15, fq = lane >> 4;
    const bf16_t* ap = A + (size_t)(row0 + 16 * wid + fr) * lda + k0 + 8 * fq; const bf16_t* bp = Bt + (size_t)(n0 + fr) * ldb + k0 + 8 * fq;
    f32x4 acc = {0.f, 0.f, 0.f, 0.f};
    for (int kb = 0; kb < nk; kb += 16) {
        bf16x8 a[16], bb[16];
#pragma unroll
        for (int j = 0; j < 16; ++j) if (kb + j < nk) { a[j] = *(const bf16x8*)(ap + 32 * (kb + j)); bb[j] = *(const bf16x8*)(bp + 32 * (kb + j)); }
#pragma unroll
        for (int j = 0; j < 16; ++j) if (kb + j < nk) acc = __builtin_amdgcn_mfma_f32_16x16x32_bf16(bb[j], a[j], acc, 0, 0, 0);
    }
    return acc;
}
__device__ __forceinline__ void sg_g1(const Params& p, int l, int j, int wid, int lane) {
    const bf16_t* A = (const bf16_t*)(p.ws + WS_A2); const bf16_t* Bt = (const bf16_t*)(p.ws + WS_WB1) + (size_t)(l * 2 + j) * 5632 * 1024; bf16_t* H = (bf16_t*)(p.ws + WS_PROJ);
    const int fr = lane & 15, fq = lane >> 4;
    for (int it = blockIdx.x; it < 176; it += gridDim.x) {
        const int c0 = 16 * it, rg = 256 * (c0 >> 7) + (c0 & 127);
        const f32x4 g = sg_dot(A, 1024, MP, Bt, 1024, rg, 0, 32, wid, lane), u = sg_dot(A, 1024, MP, Bt, 1024, rg + 128, 0, 32, wid, lane);
        *(u32x2*)(H + (size_t)(MP + 16 * wid + fr) * DFF + c0 + 4 * fq) = (u32x2){pk2(silu_f(g[0]) * u[0], silu_f(g[1]) * u[1]), pk2(silu_f(g[2]) * u[2], silu_f(g[3]) * u[3])};
    }
}
__device__ __forceinline__ void sg_resid(const Params& p, const bf16_t* A, int K, const bf16_t* Bt, const float* gate, float coef, const float* ssq, int wid, int lane) {
    const int fr = lane & 15, fq = lane >> 4, row = MP + 16 * wid + fr; const int kq = K >> 2;
    for (int it = blockIdx.x; it < 256; it += gridDim.x) {
        const int ct = it >> 2, ks = it & 3;
        f32x4 acc = sg_dot(A, K, MP, Bt, K, 16 * ct, ks * kq, kq >> 5, wid, lane);
        if (ssq && ks < 2) { const f32x4* sp = (const f32x4*)(ssq + (size_t)row * 16); const f32x4 s4 = sp[0] + sp[1] + sp[2] + sp[3]; acc *= rsqrtf((s4[0] + s4[1] + s4[2] + s4[3]) * (1.f / 1024.f) + 1e-6f); }
        const f32x4 gv = *(const f32x4*)(gate + (size_t)modrow(row) * 9216 + 16 * ct + 4 * fq);
        float* xp = p.out + (size_t)row * DM + 16 * ct + 4 * fq;
#pragma unroll
        for (int r = 0; r < 4; ++r) atomicAdd(xp + r, coef * gv[r] * acc[r]);
    }
}
__device__ __forceinline__ void sg_in(const Params& p, int l, int wid, int lane) {
    const bf16_t* A = (const bf16_t*)(p.ws + WS_A2); const bf16_t* Bt = (const bf16_t*)(p.ws + WS_WBIN) + (size_t)l * DINP * 1024; bf16_t* P = (bf16_t*)(p.ws + WS_PROJ); float* DT = (float*)(p.ws + WS_DT);
    const int fr = lane & 15, fq = lane >> 4;
    for (int it = blockIdx.x; it < 289 + 256; it += gridDim.x) {
        const int ct = it < 289 ? it : 288, row0 = it < 289 ? MP : 128 * (it - 289);
        const f32x4 acc = sg_dot(A, 1024, row0, Bt, 1024, 16 * ct, 0, 32, wid, lane);
        const int row = row0 + 16 * wid + fr;
        if (ct < 288) *(u32x2*)(P + (size_t)row * PROJW + 16 * ct + 4 * fq) = (u32x2){pk2(acc[0], acc[1]), pk2(acc[2], acc[3])};
        else *(f32x4*)(DT + (size_t)row * 16 + 4 * fq) = acc;
    }
}

__device__ __forceinline__ void p0_gemv(const Params& p, int u, unsigned char* smem, int tid, int wid, int lane) {
    const float* src; const float* bias; float* dst; int ld, n0;
    if (u < 288) { const int l = u / 72; n0 = (u % 72) * 128; src = p.in[6] + (size_t)l * 1024 * 9216; bias = p.in[7] + l * 9216; dst = (float*)(p.ws + WS_MOD) + (size_t)l * 24 * 9216; ld = 9216; }
    else { n0 = (u - 288) * 128; src = p.in[23]; bias = p.in[24]; dst = (float*)(p.ws + WS_MODF); ld = 2048; }
    const int i = lane & 31, kh = lane >> 5; const bool valid = i < 24;
    const float* cptr = (i < 16 ? p.in[4] + i * 1024 : p.in[5] + ((valid ? i : 16) - 16) * 1024) + wid * 128 + kh;
    const float* sp = src + (size_t)(wid * 128 + kh) * ld + n0 + 4 * i;
    f32x16 acc0, acc1, acc2, acc3;
    for (int r = 0; r < 16; ++r) { acc0[r] = 0.f; acc1[r] = 0.f; acc2[r] = 0.f; acc3[r] = 0.f; }
    for (int kb = 0; kb < 128; kb += 16) {
        f32x4 bw[8]; float cv[8];
#pragma unroll
        for (int j = 0; j < 8; ++j) { bw[j] = *(const f32x4*)(sp + (size_t)(kb + 2 * j) * ld); cv[j] = cptr[kb + 2 * j]; }
#pragma unroll
        for (int j = 0; j < 8; ++j) { const float a = valid ? silu_f(cv[j]) : 0.f;
            acc0 = __builtin_amdgcn_mfma_f32_32x32x2f32(a, bw[j][0], acc0, 0, 0, 0); acc1 = __builtin_amdgcn_mfma_f32_32x32x2f32(a, bw[j][1], acc1, 0, 0, 0);
            acc2 = __builtin_amdgcn_mfma_f32_32x32x2f32(a, bw[j][2], acc2, 0, 0, 0); acc3 = __builtin_amdgcn_mfma_f32_32x32x2f32(a, bw[j][3], acc3, 0, 0, 0); }
    }
    float* red = (float*)smem;
#pragma unroll
    for (int r = 0; r < 12; ++r) { float* q = red + ((wid * 4) * 12 + r) * 64 + lane; q[0] = acc0[r]; q[12 * 64] = acc1[r]; q[24 * 64] = acc2[r]; q[36 * 64] = acc3[r]; }
    LDS_BARRIER();
#pragma unroll
    for (int t = 0; t < 6; ++t) { const int idx = tid + 512 * t, c = idx / 768, r = (idx % 768) >> 6, ln = idx & 63;
        float s = 0.f;
#pragma unroll
        for (int w = 0; w < 8; ++w) s += red[((w * 4 + c) * 12 + r) * 64 + ln];
        const int row = (r & 3) + 8 * (r >> 2) + 4 * (ln >> 5), col = n0 + 4 * (ln & 31) + c;
        dst[(size_t)row * ld + col] = s + bias[col]; }
    LDS_BARRIER();
}
struct CvtUnit { const float* src; bf16_t* dst; const float* scale; const float* fallback; int ld_src, ldd, ncolrem; };
__device__ __forceinline__ CvtUnit p0_cvt_decode(const Params& p, int idx) {
    CvtUnit c; c.scale = nullptr; c.fallback = p.in[20]; c.ncolrem = 1 << 30; int R0, kk0, k0s, srccol0;
    if (idx < 5632) { const int m = idx / 704, rem = idx % 704, tn = rem >> 3, tk = rem & 7; R0 = 64 * tn; kk0 = 128 * tk; k0s = kk0;
        srccol0 = ((R0 >> 7) & 1) * DFF + 128 * (R0 >> 8) + (R0 & 127); c.src = p.in[9] + (size_t)m * 1024 * 5632; c.ld_src = 5632; c.dst = (bf16_t*)(p.ws + WS_WB1) + (size_t)m * 5632 * 1024; c.ldd = 1024; }
    else if (idx < 8448) { idx -= 5632; const int m = idx / 352, rem = idx % 352, tn = rem / 22, tk = rem % 22; R0 = 64 * tn; kk0 = 128 * tk; k0s = kk0; srccol0 = R0;
        c.src = p.in[10] + (size_t)m * DFF * 1024; c.ld_src = 1024; c.dst = (bf16_t*)(p.ws + WS_WB2) + (size_t)m * 1024 * DFF; c.ldd = DFF; }
    else if (idx < 10880) { idx -= 8448; const int l = idx / 608, rem = idx % 608, tn = rem >> 3, tk = rem & 7; R0 = 64 * tn; kk0 = 128 * tk; k0s = kk0; srccol0 = R0; c.ncolrem = DIN - srccol0;
        c.src = p.in[11] + (size_t)l * 1024 * DIN; c.ld_src = DIN; c.dst = (bf16_t*)(p.ws + WS_WBIN) + (size_t)l * DINP * 1024; c.ldd = 1024; }
    else { idx -= 10880; const int l = idx >> 8, rem = idx & 255, tn = rem >> 4, tk = rem & 15; R0 = 64 * tn; kk0 = 128 * tk; srccol0 = R0;
        if (kk0 < 1024) { k0s = 1024 + kk0; c.scale = p.in[20] + l * 1024 + kk0; } else k0s = kk0 - 1024;
        c.src = p.in[21] + (size_t)l * 2048 * 1024; c.ld_src = 1024; c.dst = (bf16_t*)(p.ws + WS_WBOUT) + (size_t)l * 1024 * 2048; c.ldd = 2048; }
    c.src += (size_t)k0s * c.ld_src + srccol0; c.dst += (size_t)R0 * c.ldd + kk0;
    return c;
}
__device__ __forceinline__ void p0_cvt_load(const CvtUnit& c, int wid, int lane, f32x4 (&v)[4], float (&sc)[2]) {
#pragma unroll
    for (int i = 0; i < 4; ++i) { const int gi = wid + 8 * (i & 1), k = lane + 64 * (i >> 1);
        v[i] = (4 * gi < c.ncolrem) ? *(const f32x4*)(c.src + (size_t)k * c.ld_src + 4 * gi) : (f32x4){0.f, 0.f, 0.f, 0.f}; }
    const float* sp = c.scale ? c.scale : c.fallback; const float s0 = sp[lane], s1 = sp[lane + 64];
    sc[0] = s0; sc[1] = s1;
}
__device__ __forceinline__ void phase0(const Params& p, unsigned char* smem, int tid, int wid, int lane) {
    { bf16_t* wm = (bf16_t*)(p.ws + WS_WM); const float* gw = p.in[13];
      for (int i = blockIdx.x * 512 + tid; i < 4 * 8 * 128 * 128; i += gridDim.x * 512) { const int s = i & 127, t = (i >> 7) & 127; const unsigned w = pk2(gw[i], 0.f); wm[i] = s <= t ? (bf16_t)(w & 0xffffu) : (bf16_t)0; } }
    for (int u = blockIdx.x; u < 304; u += gridDim.x) p0_gemv(p, u, smem, tid, wid, lane);
    bf16_t* tile = (bf16_t*)smem;
    int u = blockIdx.x; CvtUnit cu; f32x4 v[4]; float sc[2];
    bool hs = false;
    if (u < 11904) { cu = p0_cvt_decode(p, u); p0_cvt_load(cu, wid, lane, v, sc); hs = cu.scale != nullptr; }
    while (u < 11904) {
#pragma unroll
        for (int i = 0; i < 4; ++i) { const int gi = wid + 8 * (i & 1), k = lane + 64 * (i >> 1); const float s = hs ? sc[i >> 1] : 1.f;
            const unsigned w0 = pk2(v[i][0] * s, v[i][1] * s), w1 = pk2(v[i][2] * s, v[i][3] * s);
            tile[(4 * gi + 0) * 136 + k] = (bf16_t)(w0 & 0xffffu); tile[(4 * gi + 1) * 136 + k] = (bf16_t)(w0 >> 16);
            tile[(4 * gi + 2) * 136 + k] = (bf16_t)(w1 & 0xffffu); tile[(4 * gi + 3) * 136 + k] = (bf16_t)(w1 >> 16); }
        bf16_t* dst = cu.dst; const int ldd = cu.ldd;
        const int un = u + gridDim.x;
        if (un < 11904) { cu = p0_cvt_decode(p, un); p0_cvt_load(cu, wid, lane, v, sc); hs = cu.scale != nullptr; }
        LDS_BARRIER();
#pragma unroll
        for (int i = 0; i < 2; ++i) { const int id = tid + 512 * i, n = id >> 4, c8 = (id & 15) * 8; const u32x4 w = *(const u32x4*)(tile + n * 136 + c8); *(u32x4*)(dst + (size_t)n * ldd + c8) = w; }
        LDS_BARRIER();
        u = un;
    }
}

template <bool FINAL> __device__ __forceinline__ void norm_phase(const Params& p, int l, int j, bool first, const bf16_t* xsrc, bf16_t* xb, int wid, int lane) {
    const float* g = FINAL ? p.in[22] : p.in[8] + (l * 3 + j) * 1024;
    const float* modl = FINAL ? (const float*)(p.ws + WS_MODF) : (const float*)(p.ws + WS_MOD) + (size_t)l * 24 * 9216 + (3 * j) * 1024;
    const int mstride = FINAL ? 2048 : 9216;
    bf16_t* hn = (bf16_t*)(p.ws + WS_A2);
    for (int row0 = (blockIdx.x * 8 + wid) * 2; row0 < MV; row0 += gridDim.x * 16) {
        float v[2][16]; float ss[2];
        const bool f32src = first || row0 >= MP;
#pragma unroll
        for (int q = 0; q < 2; ++q) { const int row = row0 + q;
            if (f32src) { const float* xr = row >= MP ? (first ? p.in[1] + (size_t)(row - MP) * DM : p.out + (size_t)row * DM) : p.in[0] + (size_t)row * DM;
#pragma unroll
                for (int i = 0; i < 2; ++i) { const f32x4 a = *(const f32x4*)(xr + lane * 8 + 512 * i), c4 = *(const f32x4*)(xr + lane * 8 + 512 * i + 4);
                    v[q][8 * i + 0] = a[0]; v[q][8 * i + 1] = a[1]; v[q][8 * i + 2] = a[2]; v[q][8 * i + 3] = a[3]; v[q][8 * i + 4] = c4[0]; v[q][8 * i + 5] = c4[1]; v[q][8 * i + 6] = c4[2]; v[q][8 * i + 7] = c4[3]; }
            } else {
#pragma unroll
                for (int i = 0; i < 2; ++i) { const u32x4 w = *(const u32x4*)(xsrc + (size_t)row * DM + lane * 8 + 512 * i);
                    v[q][8 * i + 0] = bflo(w.x); v[q][8 * i + 1] = bfhi(w.x); v[q][8 * i + 2] = bflo(w.y); v[q][8 * i + 3] = bfhi(w.y); v[q][8 * i + 4] = bflo(w.z); v[q][8 * i + 5] = bfhi(w.z); v[q][8 * i + 6] = bflo(w.w); v[q][8 * i + 7] = bfhi(w.w); }
            } }
#pragma unroll
        for (int q = 0; q < 2; ++q) { float s = 0.f;
#pragma unroll
            for (int e = 0; e < 16; ++e) s += v[q][e] * v[q][e];
            ss[q] = wave_sum(s); }
#pragma unroll
        for (int q = 0; q < 2; ++q) { const int row = row0 + q;
            const float rinv = rsqrtf(ss[q] * (1.f / 1024.f) + 1e-6f);
            const float* sh = modl + (size_t)modrow(row) * mstride; const float* sc = sh + 1024;
#pragma unroll
            for (int i = 0; i < 2; ++i) {
                const int c = lane * 8 + 512 * i; float o[8];
#pragma unroll
                for (int hh = 0; hh < 2; ++hh) { const f32x4 gg = *(const f32x4*)(g + c + 4 * hh), s4 = *(const f32x4*)(sc + c + 4 * hh), h4 = *(const f32x4*)(sh + c + 4 * hh);
#pragma unroll
                    for (int e = 0; e < 4; ++e) o[4 * hh + e] = (v[q][8 * i + 4 * hh + e] * rinv * gg[e]) * (1.f + s4[e]) + h4[e]; }
                if (FINAL) { *(f32x4*)(p.out + (size_t)row * DM + c) = (f32x4){o[0], o[1], o[2], o[3]}; *(f32x4*)(p.out + (size_t)row * DM + c + 4) = (f32x4){o[4], o[5], o[6], o[7]}; }
                else { *(u32x4*)(hn + (size_t)row * DM + c) = (u32x4){pk2(o[0], o[1]), pk2(o[2], o[3]), pk2(o[4], o[5]), pk2(o[6], o[7])};
                    if (first) { if (row >= MP) { *(f32x4*)(p.out + (size_t)row * DM + c) = (f32x4){v[q][8 * i], v[q][8 * i + 1], v[q][8 * i + 2], v[q][8 * i + 3]}; *(f32x4*)(p.out + (size_t)row * DM + c + 4) = (f32x4){v[q][8 * i + 4], v[q][8 * i + 5], v[q][8 * i + 6], v[q][8 * i + 7]}; }
                                 else *(u32x4*)(xb + (size_t)row * DM + c) = (u32x4){pk2(v[q][8 * i], v[q][8 * i + 1]), pk2(v[q][8 * i + 2], v[q][8 * i + 3]), pk2(v[q][8 * i + 4], v[q][8 * i + 5]), pk2(v[q][8 * i + 6], v[q][8 * i + 7])}; } }
            } }
    }
}

__device__ __forceinline__ void ld8(const bf16_t* q, float (&o)[8]) { const u32x4 w = *(const u32x4*)q; o[0] = bflo(w.x); o[1] = bfhi(w.x); o[2] = bflo(w.y); o[3] = bfhi(w.y); o[4] = bflo(w.z); o[5] = bfhi(w.z); o[6] = bflo(w.w); o[7] = bfhi(w.w); }
__device__ __forceinline__ void conv_unit(const Params& p, int l, int cu, int tid) {
    if (tid >= 384) return;
    int R0, nrows, sb = 0, ch = 0, b = 0; const bool sample = cu >= 512;
    if (!sample) { b = cu >> 5; ch = cu & 31; R0 = b * 2048 + 64 * ch; nrows = 64; } else { sb = cu - 512; R0 = MP + 16 * sb; nrows = 16; }
    const int cgi = tid % 192, half = tid / 192, c0 = cgi * 8, nr = nrows >> 1, t0 = half * nr;
    const bf16_t* proj = (const bf16_t*)(p.ws + WS_PROJ);
    bf16_t* a2 = (bf16_t*)(p.ws + WS_A2); bf16_t* bc = (bf16_t*)(p.ws + WS_BC);
    float w[4][8], bs[8], r0[8], r1[8], r2[8], cur[8];
#pragma unroll
    for (int k = 0; k < 4; ++k)
#pragma unroll
        for (int e = 0; e < 8; ++e) w[k][e] = p.in[15][(size_t)(l * 4 + k) * 1536 + c0 + e];
#pragma unroll
    for (int e = 0; e < 8; ++e) bs[e] = p.in[16][l * 1536 + c0 + e];
#pragma unroll
    for (int hh = 0; hh < 3; ++hh) {
        const int t = t0 - 3 + hh; float tmp[8];
        if (t >= 0 || (!sample && ch > 0)) ld8(proj + (size_t)(R0 + t) * PROJW + 3072 + c0, tmp);
        else if (sample) {
#pragma unroll
            for (int e = 0; e < 8; ++e) tmp[e] = p.in[3][(size_t)((l * 8 + sb) * 3 + (3 + t)) * 1536 + c0 + e];
        } else {
#pragma unroll
            for (int e = 0; e < 8; ++e) tmp[e] = 0.f;
        }
#pragma unroll
        for (int e = 0; e < 8; ++e) { if (hh == 0) r0[e] = tmp[e]; else if (hh == 1) r1[e] = tmp[e]; else r2[e] = tmp[e]; }
    }
    u32x4 raw[4], rawn[4];
#pragma unroll
    for (int q = 0; q < 4; ++q) raw[q] = *(const u32x4*)(proj + (size_t)(R0 + t0 + q) * PROJW + 3072 + c0);
#pragma unroll 1
    for (int tb = t0; tb < t0 + nr; tb += 4) {
        if (tb + 4 < t0 + nr) {
#pragma unroll
            for (int q = 0; q < 4; ++q) rawn[q] = *(const u32x4*)(proj + (size_t)(R0 + tb + 4 + q) * PROJW + 3072 + c0);
        }
#pragma unroll
        for (int q = 0; q < 4; ++q) {
            const int t = tb + q; const u32x4 w4 = raw[q];
            cur[0] = bflo(w4.x); cur[1] = bfhi(w4.x); cur[2] = bflo(w4.y); cur[3] = bfhi(w4.y); cur[4] = bflo(w4.z); cur[5] = bfhi(w4.z); cur[6] = bflo(w4.w); cur[7] = bfhi(w4.w);
            float y[8];
#pragma unroll
            for (int e = 0; e < 8; ++e) { const float a = bs[e] + w[0][e] * r0[e] + w[1][e] * r1[e] + w[2][e] * r2[e] + w[3][e] * cur[e]; y[e] = silu_f(a); }
            const u32x4 o = {pk2(y[0], y[1]), pk2(y[2], y[3]), pk2(y[4], y[5]), pk2(y[6], y[7])};
            if (c0 < 1024) *(u32x4*)(a2 + (size_t)(R0 + t) * 2048 + c0) = o; else *(u32x4*)(bc + (size_t)(R0 + t) * 512 + (c0 - 1024)) = o;
            int k = -1;
            if (!sample) { if (ch == 31 && t >= 61) k = t - 61; } else if (t >= 13) k = t - 13;
            if (k >= 0) { float* op = sample ? p.out + O_CONVS + (size_t)((l * 8 + sb) * 3 + k) * 1536 + c0 : p.out + O_CONVP + (size_t)((l * 16 + b) * 3 + k) * 1536 + c0;
                *(f32x4*)op = (f32x4){cur[0], cur[1], cur[2], cur[3]}; *(f32x4*)(op + 4) = (f32x4){cur[4], cur[5], cur[6], cur[7]}; }
#pragma unroll
            for (int e = 0; e < 8; ++e) { r0[e] = r1[e]; r1[e] = r2[e]; r2[e] = cur[e]; }
        }
#pragma unroll
        for (int q = 0; q < 4; ++q) raw[q] = rawn[q];
    }
}
struct GmU { int R0, nrows, h, sb; bool sample; };
__device__ __forceinline__ GmU gm_decode(int gu) { GmU g; g.sample = gu >= 2048; g.sb = 0;
    if (!g.sample) { const int b = gu >> 7, rem = gu & 127; g.h = rem & 7; g.R0 = b * 2048 + 128 * (rem >> 3); g.nrows = 128; } else { const int s = gu - 2048; g.sb = s >> 3; g.h = s & 7; g.R0 = MP + 16 * g.sb; g.nrows = 16; }
    return g; }
__device__ __forceinline__ void gm_load_v(const bf16_t* proj, const GmU& g, int tid, u32x4 (&vr)[4]) {
    const int i = tid >> 2, d0 = (tid & 3) * 32;
#pragma unroll
    for (int c4 = 0; c4 < 4; ++c4) vr[c4] = i < g.nrows ? *(const u32x4*)(proj + (size_t)(g.R0 + i) * PROJW + 1024 + g.h * 128 + d0 + 8 * c4) : (u32x4){0u, 0u, 0u, 0u};
}
__device__ __forceinline__ void gm_load_u(const bf16_t* proj, const GmU& g, int wid, int lane, u32x2 (&uw)[8]) {
    const int fr = lane & 15, fq = lane >> 4, t = 16 * wid + fr;
#pragma unroll
    for (int d = 0; d < 8; ++d) uw[d] = (16 * wid < g.nrows) ? *(const u32x2*)(proj + (size_t)(g.R0 + t) * PROJW + g.h * 128 + 16 * d + 4 * fq) : (u32x2){0u, 0u};
}
__device__ __forceinline__ void gmlp_units(const Params& p, int l, unsigned char* smem, int tid, int wid, int lane) {
    bf16_t* vnT = (bf16_t*)smem;
    const bf16_t* proj = (const bf16_t*)(p.ws + WS_PROJ);
    int gu = blockIdx.x; if (gu >= 2112) return;
    GmU g = gm_decode(gu); u32x4 vr[4]; u32x2 uw[8];
    gm_load_v(proj, g, tid, vr); gm_load_u(proj, g, wid, lane, uw);
    for (;;) {
        const int R0 = g.R0, nrows = g.nrows, h = g.h, sb = g.sb; const bool sample = g.sample;
        {
            const int i = tid >> 2, q = tid & 3, d0 = q * 32;
            if (i < nrows) {
                float v[32];
#pragma unroll
                for (int c4 = 0; c4 < 4; ++c4) { const u32x4 w4 = vr[c4];
                    v[8 * c4 + 0] = gelu_t(bflo(w4.x)); v[8 * c4 + 1] = gelu_t(bfhi(w4.x)); v[8 * c4 + 2] = gelu_t(bflo(w4.y)); v[8 * c4 + 3] = gelu_t(bfhi(w4.y));
                    v[8 * c4 + 4] = gelu_t(bflo(w4.z)); v[8 * c4 + 5] = gelu_t(bfhi(w4.z)); v[8 * c4 + 6] = gelu_t(bflo(w4.w)); v[8 * c4 + 7] = gelu_t(bfhi(w4.w)); }
                float s = 0.f;
#pragma unroll
                for (int e = 0; e < 32; ++e) s += v[e];
                s = quad_sum(s);
                const float mu = s * (1.f / 128.f);
                float q2 = 0.f;
#pragma unroll
                for (int e = 0; e < 32; ++e) { v[e] -= mu; q2 += v[e] * v[e]; }
                q2 = quad_sum(q2);
                const float rs = rsqrtf(q2 * (1.f / 128.f) + 1e-6f);
                const float* ng = p.in[12] + l * 1024 + h * 128 + d0;
#pragma unroll
                for (int e = 0; e < 32; ++e) v[e] = v[e] * rs * ng[e];
#pragma unroll
                for (int e = 0; e < 32; e += 2) { const unsigned w = pk2(v[e], v[e + 1]); vnT[(d0 + e) * 144 + i] = (bf16_t)(w & 0xffffu); vnT[(d0 + e + 1) * 144 + i] = (bf16_t)(w >> 16); }
                if (sample) { float* gv = p.out + O_GMV + (size_t)((l * 8 + sb) * 16 + i) * 1024 + h * 128 + d0;
#pragma unroll
                    for (int e = 0; e < 32; e += 4) *(f32x4*)(gv + e) = (f32x4){v[e], v[e + 1], v[e + 2], v[e + 3]}; }
            } else if (i < 32) {
#pragma unroll
                for (int e = 0; e < 32; ++e) vnT[(d0 + e) * 144 + i] = (bf16_t)0;
            }
        }
        const int gn = gu + gridDim.x; const bool more = gn < 2112;
        if (more) { g = gm_decode(gn); gm_load_v(proj, g, tid, vr); }
        LDS_BARRIER();
        if (16 * wid < nrows) {
            const int fr = lane & 15, fq = lane >> 4, tt = 16 * wid, nk = ((tt + 15) >> 5) + 1;
            f32x4 acc[8];
#pragma unroll
            for (int d = 0; d < 8; ++d) acc[d] = (f32x4){0.f, 0.f, 0.f, 0.f};
            const bf16_t* wm = (const bf16_t*)(p.ws + WS_WM) + (size_t)((l * 8 + h) * 128 + tt + fr) * 128 + 8 * fq;
            for (int kk = 0; kk < nk; ++kk) {
                const bf16x8 bfr = *(const bf16x8*)(wm + 32 * kk);
#pragma unroll
                for (int d = 0; d < 8; ++d) { const bf16x8 afr = *(const bf16x8*)(vnT + (16 * d + fr) * 144 + 32 * kk + 8 * fq); acc[d] = __builtin_amdgcn_mfma_f32_16x16x32_bf16(afr, bfr, acc[d], 0, 0, 0); }
            }
            const int t = tt + fr; const float bias = p.in[14][(l * 8 + h) * 128 + t];
            bf16_t* a2 = (bf16_t*)(p.ws + WS_A2);
#pragma unroll
            for (int d = 0; d < 8; ++d) {
                const int dcol = h * 128 + 16 * d + 4 * fq;
                const float o0 = gelu_t(bflo(uw[d].x)) * (acc[d][0] + bias), o1 = gelu_t(bfhi(uw[d].x)) * (acc[d][1] + bias), o2 = gelu_t(bflo(uw[d].y)) * (acc[d][2] + bias), o3 = gelu_t(bfhi(uw[d].y)) * (acc[d][3] + bias);
                *(u32x2*)(a2 + (size_t)(R0 + t) * 2048 + 1024 + dcol) = (u32x2){pk2(o0, o1), pk2(o2, o3)};
            }
        }
        if (!more) { LDS_BARRIER(); break; }
        gm_load_u(proj, g, wid, lane, uw);
        LDS_BARRIER();
        gu = gn;
    }
}

__device__ __forceinline__ unsigned tr_addr(unsigned base_b, int stride, int k0, int R0, int lane) {
    const int fq = lane >> 4, i = lane & 15; return base_b + (unsigned)(((k0 + 8 * fq + (i >> 2)) * stride + R0 + 4 * (i & 3)) * 2);
}
#define TR_READ2(lo, hi, addr, stride) asm volatile("ds_read_b64_tr_b16 %0, %2\n\tds_read_b64_tr_b16 %1, %2 offset:%3" : "=&v"(lo), "=&v"(hi) : "v"(addr), "n"(4 * (stride) * 2) : "memory")
#define TR_FRAG(lo, hi) ((bf16x8)__builtin_bit_cast(bf16x8, (u32x4){(lo).x, (lo).y, (hi).x, (hi).y}))

__device__ __forceinline__ void ssd_unit(const Params& p, int l, int su, unsigned char* smem, int tid, int wid, int lane, bool ystore) {
    int RB, nch, nL, h; const float* h0 = nullptr; float* hout;
    if (su < 256) { const int b = su >> 4; h = su & 15; RB = b * 2048; nch = 32; nL = 64; hout = p.out + O_SSMP + (size_t)((l * 16 + b) * 16 + h) * 8192; }
    else { const int s = su - 256, sb = s >> 4; h = s & 15; RB = MP + 16 * sb; nch = 1; nL = 16; h0 = p.in[2] + (size_t)((l * 8 + sb) * 16 + h) * 8192; hout = p.out + O_SSMS + (size_t)((l * 8 + sb) * 16 + h) * 8192; }
    const int g = h >> 3, fr = lane & 15, fq = lane >> 4;
    bf16_t* Cs = (bf16_t*)smem; bf16_t* Bs = Cs + 64 * 144; bf16_t* Hb = Bs + 64 * 144; bf16_t* BT = Hb + 64 * 144; bf16_t* XT = BT + 128 * 80; bf16_t* XdT = XT + 64 * 80; bf16_t* Gs = XdT + 64 * 80;
    bf16_t* Zs = Gs + 64 * 80; bf16_t* Xs = Zs + 64 * 80; float* acs = (float*)(Xs + 64 * 80); float* dts = acs + 64; float* ssq2 = dts + 64;
    const bf16_t* proj = (const bf16_t*)(p.ws + WS_PROJ); const bf16_t* bc = (const bf16_t*)(p.ws + WS_BC); bf16_t* a2 = (bf16_t*)(p.ws + WS_A2);
    const unsigned xs_b = (unsigned)((unsigned char*)Xs - smem), bs_b = (unsigned)((unsigned char*)Bs - smem), xd_b = (unsigned)((unsigned char*)XdT - smem);
    const float* dtraw = (const float*)(p.ws + WS_DT); float* ssq = (float*)(p.ws + WS_SSQ);
    const float dtb = p.in[17][l * 16 + h], aneg = -__expf(p.in[18][l * 16 + h]), dsk = p.in[19][l * 16 + h];
    f32x4 st[4];
#pragma unroll
    for (int pt = 0; pt < 4; ++pt) st[pt] = h0 ? *(const f32x4*)(h0 + (size_t)(16 * pt + fr) * 128 + 16 * wid + 4 * fq) : (f32x4){0.f, 0.f, 0.f, 0.f};
    u32x4 px, pz, pb[2], pc[2]; float pdt;
    const int xrow = lane, xseg = wid;
#define SSD_LOAD(R0) do { const u32x4 z4 = {0u, 0u, 0u, 0u}; \
        px = xrow < nL ? *(const u32x4*)(a2 + (size_t)((R0) + xrow) * 2048 + h * 64 + xseg * 8) : z4; \
        pz = xrow < nL ? *(const u32x4*)(proj + (size_t)((R0) + xrow) * PROJW + 2048 + h * 64 + xseg * 8) : z4; \
        _Pragma("unroll") for (int i = 0; i < 2; ++i) { const int row = lane, seg = wid + 8 * i; \
            pb[i] = row < nL ? *(const u32x4*)(bc + (size_t)((R0) + row) * 512 + g * 128 + seg * 8) : z4; \
            pc[i] = row < nL ? *(const u32x4*)(bc + (size_t)((R0) + row) * 512 + 256 + g * 128 + seg * 8) : z4; } \
        pdt = lane < nL ? dtraw[(size_t)((R0) + lane) * 16 + h] : 0.f; } while (0)
    SSD_LOAD(RB);
    for (int c = 0; c < nch; ++c) {
        const int R0 = RB + 64 * c;
        *(u32x4*)(Xs + xrow * 80 + xseg * 8) = px; *(u32x4*)(Zs + xrow * 80 + xseg * 8) = pz;
#pragma unroll
        for (int i = 0; i < 2; ++i) { const int row = lane, seg = wid + 8 * i;
            *(u32x4*)(Bs + row * 144 + seg * 8) = pb[i]; *(u32x4*)(Cs + row * 144 + seg * 8) = pc[i];
        }
#pragma unroll
        for (int pt = 0; pt < 4; ++pt) *(u32x2*)(Hb + (16 * pt + fr) * 144 + 16 * wid + 4 * fq) = (u32x2){pk2(st[pt][0], st[pt][1]), pk2(st[pt][2], st[pt][3])};
        { const float dtv = lane < nL ? softplus_f(pdt + dtb) : 0.f; float ac = dtv * aneg;
#define DPP_ADD(ctrl, rmask) ac += __int_as_float(__builtin_amdgcn_update_dpp(0, __float_as_int(ac), ctrl, rmask, 0xf, true))
          DPP_ADD(0x111, 0xf); DPP_ADD(0x112, 0xf); DPP_ADD(0x114, 0xf); DPP_ADD(0x118, 0xf); DPP_ADD(0x142, 0xa); DPP_ADD(0x143, 0xc);
#undef DPP_ADD
          if (wid == 0) { acs[lane] = ac; dts[lane] = dtv; }
          const float wgt = __expf(__int_as_float(__builtin_amdgcn_readlane(__float_as_int(ac), 63)) - ac) * dtv;
          *(u32x4*)(XdT + xrow * 80 + xseg * 8) = (u32x4){pk2(bflo(px.x) * wgt, bfhi(px.x) * wgt), pk2(bflo(px.y) * wgt, bfhi(px.y) * wgt), pk2(bflo(px.z) * wgt, bfhi(px.z) * wgt), pk2(bflo(px.w) * wgt, bfhi(px.w) * wgt)}; }
        if (c + 1 < nch) SSD_LOAD(R0 + 64);
        LDS_BARRIER();
        const float acL = acs[63];
        { const int lt = wid >> 1;
#pragma unroll
          for (int q = 0; q < 2; ++q) { const int stl = 2 * (wid & 1) + q; const int lrow = 16 * lt + fr, s0 = 16 * stl + 4 * fq;
              u32x2 o = {0u, 0u};
              if (stl <= lt) {
                  f32x4 acc = {0.f, 0.f, 0.f, 0.f};
#pragma unroll
                  for (int kk = 0; kk < 4; ++kk) { const bf16x8 a = *(const bf16x8*)(Bs + (16 * stl + fr) * 144 + 32 * kk + 8 * fq), b = *(const bf16x8*)(Cs + (16 * lt + fr) * 144 + 32 * kk + 8 * fq); acc = __builtin_amdgcn_mfma_f32_16x16x32_bf16(a, b, acc, 0, 0, 0); }
                  const float al = acs[lrow]; const f32x4 as4 = *(const f32x4*)(acs + s0), dt4 = *(const f32x4*)(dts + s0);
                  float gg[4];
#pragma unroll
                  for (int r = 0; r < 4; ++r) gg[r] = (s0 + r <= lrow) ? acc[r] * __expf(al - as4[r]) * dt4[r] : 0.f;
                  o = (u32x2){pk2(gg[0], gg[1]), pk2(gg[2], gg[3])};
              }
              *(u32x2*)(Gs + lrow * 80 + s0) = o; } }
        LDS_BARRIER();
        { const int lt = wid >> 1, lrow = 16 * lt + fr; const float el = __expf(acs[lrow]); float sq = 0.f;
#pragma unroll
          for (int q = 0; q < 2; ++q) { const int pt = 2 * (wid & 1) + q, p0 = 16 * pt + 4 * fq;
              f32x4 ad = {0.f, 0.f, 0.f, 0.f}, ao = {0.f, 0.f, 0.f, 0.f};
              { u32x2 t0, t1, t2, t3; const unsigned ax = tr_addr(xs_b, 80, 0, 16 * pt, lane);
                TR_READ2(t0, t1, ax, 80); TR_READ2(t2, t3, ax + 32 * 80 * 2, 80);
                const bf16x8 b0 = *(const bf16x8*)(Gs + lrow * 80 + 8 * fq), b1 = *(const bf16x8*)(Gs + lrow * 80 + 32 + 8 * fq);
                asm volatile("s_waitcnt lgkmcnt(0)" : "+v"(t0), "+v"(t1), "+v"(t2), "+v"(t3) :: "memory");
                ad = __builtin_amdgcn_mfma_f32_16x16x32_bf16(TR_FRAG(t0, t1), b0, ad, 0, 0, 0); ad = __builtin_amdgcn_mfma_f32_16x16x32_bf16(TR_FRAG(t2, t3), b1, ad, 0, 0, 0); }
#pragma unroll
              for (int kk = 0; kk < 4; ++kk) { const bf16x8 a = *(const bf16x8*)(Hb + (16 * pt + fr) * 144 + 32 * kk + 8 * fq), b = *(const bf16x8*)(Cs + lrow * 144 + 32 * kk + 8 * fq); ao = __builtin_amdgcn_mfma_f32_16x16x32_bf16(a, b, ao, 0, 0, 0); }
              const u32x2 xw = *(const u32x2*)(Xs + lrow * 80 + p0), zw = *(const u32x2*)(Zs + lrow * 80 + p0);
              const float xv[4] = {bflo(xw.x), bfhi(xw.x), bflo(xw.y), bfhi(xw.y)}, zv[4] = {bflo(zw.x), bfhi(zw.x), bflo(zw.y), bfhi(zw.y)};
              float y[4];
#pragma unroll
              for (int r = 0; r < 4; ++r) { y[r] = (ad[r] + el * ao[r] + dsk * xv[r]) * silu_f(zv[r]); sq += y[r] * y[r]; }
              if (lrow < nL && ystore) *(u32x2*)(a2 + (size_t)(R0 + lrow) * 2048 + h * 64 + p0) = (u32x2){pk2(y[0], y[1]), pk2(y[2], y[3])}; }
          ssq2[lrow * 8 + (wid & 1) * 4 + fq] = sq; }
        { const float eL = __expf(acL);
          u32x2 a0, a1, a2, a3, x0[4], x1[4], x2[4], x3[4];
          const unsigned ab = tr_addr(bs_b, 144, 0, 16 * wid, lane), xb0 = tr_addr(xd_b, 80, 0, 0, lane);
          TR_READ2(a0, a1, ab, 144); TR_READ2(a2, a3, ab + 32 * 144 * 2, 144);
#pragma unroll
          for (int pt = 0; pt < 4; ++pt) { TR_READ2(x0[pt], x1[pt], xb0 + 16 * pt * 2, 80); TR_READ2(x2[pt], x3[pt], xb0 + 16 * pt * 2 + 32 * 80 * 2, 80); }
          asm volatile("s_waitcnt lgkmcnt(0)" : "+v"(a0), "+v"(a1), "+v"(a2), "+v"(a3), "+v"(x0[0]), "+v"(x1[0]), "+v"(x2[0]), "+v"(x3[0]), "+v"(x0[1]), "+v"(x1[1]), "+v"(x2[1]), "+v"(x3[1]),
                       "+v"(x0[2]), "+v"(x1[2]), "+v"(x2[2]), "+v"(x3[2]), "+v"(x0[3]), "+v"(x1[3]), "+v"(x2[3]), "+v"(x3[3]) :: "memory");
#pragma unroll
          for (int pt = 0; pt < 4; ++pt) { f32x4 acc = {0.f, 0.f, 0.f, 0.f};
              acc = __builtin_amdgcn_mfma_f32_16x16x32_bf16(TR_FRAG(a0, a1), TR_FRAG(x0[pt], x1[pt]), acc, 0, 0, 0);
              acc = __builtin_amdgcn_mfma_f32_16x16x32_bf16(TR_FRAG(a2, a3), TR_FRAG(x2[pt], x3[pt]), acc, 0, 0, 0);
              st[pt] = eL * st[pt] + acc; } }
        LDS_BARRIER();
        if (tid < nL) { const f32x4 q0 = *(const f32x4*)(ssq2 + tid * 8), q1 = *(const f32x4*)(ssq2 + tid * 8 + 4); ssq[(size_t)(R0 + tid) * 16 + h] = (q0[0] + q0[1]) + (q0[2] + q0[3]) + (q1[0] + q1[1]) + (q1[2] + q1[3]); }
    }
#undef SSD_LOAD
#pragma unroll
    for (int pt = 0; pt < 4; ++pt) *(f32x4*)(hout + (size_t)(16 * pt + fr) * 128 + 16 * wid + 4 * fq) = st[pt];
    LDS_BARRIER();
}

__global__ void __launch_bounds__(512, 2) mk_fwd(Params p) {
    extern __shared__ __attribute__((aligned(16))) unsigned char smem[];
    cg::grid_group grid = cg::this_grid();
    volatile LAS unsigned* xst = (volatile LAS unsigned*)(smem + 131072 + 3072);
    if (threadIdx.x == 0) { xst[0] = 0u; xst[1] = 0u; }
    __syncthreads();
    const XcdBarrier xb = xcd_barrier_post((unsigned*)(p.ws + WS_BAR), xst);
    for (int ph = p.ph_lo; ph < p.ph_hi; ++ph) {
        if (ph > p.ph_lo) {
            if (ph == p.ph_lo + 1) grid.sync(); else xcd_barrier(xb);
#if defined(PROBE_DUP) && (PROBE_DUP & 32)
            xcd_barrier(xb);
#endif
        }
        const int l = ph == 0 ? 0 : (ph - 1) / 11, s = ph == 0 ? 100 : (ph == NPH - 1 ? 101 : (ph - 1) % 11);
        int nrep = 1;
#if defined(PROBE_DUP)
        if ((PROBE_DUP & 1) && s == 100) nrep = 2;
        if ((PROBE_DUP & 2) && (s == 0 || s == 3 || s == 8)) nrep = 2;
        if ((PROBE_DUP & 4) && (s == 1 || s == 9)) nrep = 2;
        if ((PROBE_DUP & 8) && s == 4) nrep = 2;
        if ((PROBE_DUP & 16) && s == 5) nrep = 2;
        if ((PROBE_DUP & 64) && (s == 2 || s == 10)) nrep = 2;
        if ((PROBE_DUP & 128) && s == 7) nrep = 2;
        if ((PROBE_DUP & 256) && s == 6) nrep = 2;
#endif
      for (int rep = 0; rep < nrep; ++rep) {
        if (rep) xcd_barrier(xb);
        int tid_raw = threadIdx.x; asm volatile("" : "+v"(tid_raw));
        const int tid = tid_raw, wid = __builtin_amdgcn_readfirstlane(tid >> 6), lane = tid & 63;
        if (s == 100) {
#ifndef SKIP_P0
            phase0(p, smem, tid, wid, lane);
#endif
            continue; }
        if (s == 101) {
#ifndef SKIP_NORM
            norm_phase<true>(p, 0, 0, false, (const bf16_t*)(p.ws + WS_A2), nullptr, wid, lane);
#endif
            continue; }
        const float* modl = (const float*)(p.ws + WS_MOD) + (size_t)l * 24 * 9216;
        bf16_t* xb = (bf16_t*)((unsigned char*)p.out + 67108864);
        if (s == 0 || s == 3 || s == 8) {
#ifndef SKIP_NORM
 norm_phase<false>(p, l, s == 0 ? 0 : (s == 3 ? 1 : 2), ph == 1, xb, xb, wid, lane);
#endif
 }
        else if (s == 1 || s == 9) { const int j = s == 9;
            pg8::Gemm g{(const bf16_t*)(p.ws + WS_A2), (const bf16_t*)(p.ws + WS_WB1) + (size_t)(l * 2 + j) * 5632 * 1024, MP, 5632, 1024};
            pg8::StaticOrder S; S.init(g.M, g.N, (int)gridDim.x, (int)blockIdx.x);
            EpiSwiglu E{(bf16_t*)(p.ws + WS_PROJ), 0};
#ifndef SKIP_G1
            sg_g1(p, l, j, wid, lane);
            pg8::gemm_phase<EpiSwiglu, pg8::StaticOrder, false>((PG8_LAS unsigned char*)smem, g, S, E, nullptr);
#endif
 }
        else if (s == 2 || s == 10) { const int j = s == 10;
            pg8::Gemm g{(const bf16_t*)(p.ws + WS_PROJ), (const bf16_t*)(p.ws + WS_WB2) + (size_t)(l * 2 + j) * 1024 * DFF, MP, 1024, DFF};
            SwapOrder S; S.init(g.M, g.N, (int)gridDim.x, (int)blockIdx.x);
            EpiResid<false> E{(l == 3 && j == 1 && rep + 1 == nrep) ? (bf16_t*)(p.ws + WS_A2) : xb, xb, modl + (j ? 8 : 2) * 1024, (rep + 1 < nrep) ? 0.f : 0.5f, nullptr, 0};
#ifndef SKIP_G2
            sg_resid(p, g.A, DFF, g.Bt, E.gate, E.coef, nullptr, wid, lane);
            pg8::gemm_phase<EpiResid<false>, SwapOrder, false>((PG8_LAS unsigned char*)smem, g, S, E, nullptr);
#endif
 }
        else if (s == 4) {
            pg8::Gemm g{(const bf16_t*)(p.ws + WS_A2), (const bf16_t*)(p.ws + WS_WBIN) + (size_t)l * DINP * 1024, MP, PROJW, 1024};
            pg8::StaticOrder S; S.init(g.M, g.N, (int)gridDim.x, (int)blockIdx.x);
            EpiProj E{(bf16_t*)(p.ws + WS_PROJ), nullptr, 0};
#ifndef SKIP_GIN
            sg_in(p, l, wid, lane);
            pg8::gemm_phase<EpiProj, pg8::StaticOrder, false>((PG8_LAS unsigned char*)smem, g, S, E, nullptr);
#endif
 }
        else if (s == 5) {
#ifndef SKIP_MIXA
#ifndef SKIP_GM
            gmlp_units(p, l, smem, tid, wid, lane);
#endif
#ifndef SKIP_CONV
            for (int u = blockIdx.x; u < 520; u += gridDim.x) conv_unit(p, l, u, tid);
#endif
#endif
 }
        else if (s == 6) { for (int u = blockIdx.x; u < 384; u += gridDim.x) {
#ifndef SKIP_SSD
 ssd_unit(p, l, u, smem, tid, wid, lane, rep + 1 == nrep);
#endif
 } }
        else {
            pg8::Gemm g{(const bf16_t*)(p.ws + WS_A2), (const bf16_t*)(p.ws + WS_WBOUT) + (size_t)l * 1024 * 2048, MP, 1024, 2048};
            pg8::StaticOrder S; S.init(g.M, g.N, (int)gridDim.x, (int)blockIdx.x);
            float* rl = (float*)(smem + 131072);
            { const float* ssq = (const float*)(p.ws + WS_SSQ);
              for (int i = 0; i < 2; ++i) { pg8::Unit uu; if (!S.next(i, uu)) break;
                  if (tid < 256) { const f32x4* sp = (const f32x4*)(ssq + (size_t)(uu.pm * 256 + tid) * 16); const f32x4 s4 = sp[0] + sp[1] + sp[2] + sp[3];
                      rl[i * 256 + tid] = rsqrtf((s4[0] + s4[1] + s4[2] + s4[3]) * (1.f / 1024.f) + 1e-6f); } }
              __syncthreads(); }
            EpiResid<true> E{xb, xb, modl + 5 * 1024, (rep + 1 < nrep) ? 0.f : 1.0f, rl, 16};
#ifndef SKIP_GOUT
            sg_resid(p, g.A, 2048, g.Bt, E.gate, E.coef, (const float*)(p.ws + WS_SSQ), wid, lane);
            pg8::gemm_phase<EpiResid<true>, pg8::StaticOrder, false>((PG8_LAS unsigned char*)smem, g, S, E, nullptr);
#endif
 }
      }
    }
}

extern "C" void kernel_launch(void* const* d_in, const int* in_sizes, int n_in, void* d_out, int out_size, void* d_ws, size_t ws_size, hipStream_t stream) {
    static int grid = 0;
    if (grid == 0) {
        if (n_in != 25 || ws_size < WS_END) { fprintf(stderr, "kernel_launch: unexpected n_in %d or workspace %zu < %zu\n", n_in, ws_size, (size_t)WS_END); grid = -1; return; }
        int dev = 0, cus = 0, per_cu = 0;
        hipGetDevice(&dev); hipDeviceGetAttribute(&cus, hipDeviceAttributeMultiprocessorCount, dev);
        if (hipFuncSetAttribute((const void*)mk_fwd, hipFuncAttributeMaxDynamicSharedMemorySize, LDS_BYTES) != hipSuccess) { fprintf(stderr, "kernel_launch: hipFuncSetAttribute failed\n"); grid = -1; return; }
        if (hipOccupancyMaxActiveBlocksPerMultiprocessor(&per_cu, (const void*)mk_fwd, 512, LDS_BYTES) != hipSuccess || per_cu < 1) { fprintf(stderr, "kernel_launch: occupancy query gave %d\n", per_cu); per_cu = 1; (void)hipGetLastError(); }
        grid = cus * (per_cu > 1 ? 1 : per_cu);
    }
    if (grid < 0) return;
    Params p{};
    for (int i = 0; i < 25; ++i) p.in[i] = (const float*)d_in[i];
    p.out = (float*)d_out; p.ws = (unsigned char*)d_ws;
#if MK_MULTI
    for (int ph = 0; ph < NPH; ++ph) { p.ph_lo = ph; p.ph_hi = ph + 1; hipLaunchKernelGGL(mk_fwd, dim3(grid), dim3(512), LDS_BYTES, stream, p); }
#else
    p.ph_lo = 0; p.ph_hi = NPH;
    if (hipMemsetAsync((unsigned char*)d_ws + WS_BAR, 0, 16384, stream) != hipSuccess) { fprintf(stderr, "kernel_launch: memset of the barrier words failed\n"); return; }
    void* args[] = {&p};
    const hipError_t e = hipLaunchCooperativeKernel((const void*)mk_fwd, dim3(grid), dim3(512), args, LDS_BYTES, stream);
    if (e != hipSuccess) fprintf(stderr, "kernel_launch: cooperative launch failed: %s (grid %d)\n", hipGetErrorString(e), grid);
#endif
}
```
